# Optimizing an MI355X kernel written in HIP

```python
import math
import jax
import jax.numpy as jnp
from jax import lax
import numpy as np

D_MODEL = 1024
BATCH = 16
SEQ = 2048
DEPTH = 2

GRID_W = 64
CTX_LEN = 256
HEAD_DIM = 64
N_GROUPS = 4
D_MIX = D_MODEL
GROUP_W = D_MIX // N_GROUPS
ATT_HEADS = GROUP_W // HEAD_DIM
ATT_KV_HEADS = 2
NA_HEADS = GROUP_W // HEAD_DIM
WIN_H = 8
WIN_W = 16
FNO_HEADS = 4
FNO_HEAD_W = GROUP_W // FNO_HEADS
SSM_GROUP = 16
SSM_GROUPS = GROUP_W // SSM_GROUP
SSM_STATE = 64
Q_BLOCK = 128
ROPE_THETA = 10000.0
D_FF = ((8 * D_MODEL // 3 + 255) // 256) * 256
N_MOD = 6
EPS = 1e-6
ATT_Q_W = ATT_HEADS * HEAD_DIM
ATT_KV_W = ATT_KV_HEADS * HEAD_DIM
NA_W = NA_HEADS * HEAD_DIM
PROJ_WIDTHS = (ATT_Q_W, ATT_KV_W, ATT_KV_W, NA_W, NA_W, NA_W, GROUP_W, GROUP_W)
IN_W = sum(PROJ_WIDTHS)

kernel_name = 'hybrid_parallel_heads_diffusion_block'


def _rmsnorm(t, g):
    tf = t.astype(jnp.float32)
    y = tf * lax.rsqrt(jnp.mean(tf * tf, axis=-1, keepdims=True) + EPS)
    return (y * g.astype(jnp.float32)).astype(t.dtype)


def _split_proj(p):
    outs, start = [], 0
    for w in PROJ_WIDTHS:
        outs.append(p[..., start:start + w])
        start += w
    return outs


def _heads(t, n_heads):
    b, n, _ = t.shape
    return t.reshape(b, n, n_heads, HEAD_DIM).transpose(0, 2, 1, 3)


def _merge_heads(t):
    b, h, n, d = t.shape
    return t.transpose(0, 2, 1, 3).reshape(b, n, h * d)


def _rope_tables(n_tokens):
    t = jnp.arange(n_tokens, dtype=jnp.int32)
    rows = (t // GRID_W).astype(jnp.float32)
    cols = (t % GRID_W).astype(jnp.float32)
    axis_dim = HEAD_DIM // 2
    inv_freq = ROPE_THETA ** (-jnp.arange(0, axis_dim, 2, dtype=jnp.float32) / axis_dim)
    ang_r = rows[:, None] * inv_freq[None, :]
    ang_c = cols[:, None] * inv_freq[None, :]
    return (jnp.cos(ang_r), jnp.sin(ang_r), jnp.cos(ang_c), jnp.sin(ang_c))


def _rotate(t, cos, sin):
    t1, t2 = jnp.split(t, 2, axis=-1)
    return jnp.concatenate([t1 * cos - t2 * sin, t2 * cos + t1 * sin], axis=-1)


def _apply_rope_2d(t, rope):
    cos_r, sin_r, cos_c, sin_c = rope
    tr, tc = jnp.split(t, 2, axis=-1)
    out = jnp.concatenate([_rotate(tr, cos_r, sin_r), _rotate(tc, cos_c, sin_c)], axis=-1)
    return out.astype(t.dtype)


def _gqa_mixer(q, k, v, qc, kc, vc, gq, gk, rope, need_ctx):
    b, n, _ = q.shape
    nc = qc.shape[1]
    rep = ATT_HEADS // ATT_KV_HEADS
    scale = HEAD_DIM ** -0.5
    qh = _apply_rope_2d(_rmsnorm(_heads(q, ATT_HEADS), gq), rope)
    kh = _apply_rope_2d(_rmsnorm(_heads(k, ATT_KV_HEADS), gk), rope)
    vh = _heads(v, ATT_KV_HEADS)
    kch = _rmsnorm(_heads(kc, ATT_KV_HEADS), gk)
    vch = _heads(vc, ATT_KV_HEADS)
    keys = jnp.concatenate([kh, kch], axis=2)
    vals = jnp.concatenate([vh, vch], axis=2)
    n_blk = n // Q_BLOCK
    q_blocks = jnp.moveaxis(qh.reshape(b, ATT_KV_HEADS, rep, n_blk, Q_BLOCK, HEAD_DIM), 3, 0)

    def block(qb):
        s = jnp.einsum('bgrqd,bgkd->bgrqk', qb, keys).astype(jnp.float32) * scale
        p = jax.nn.softmax(s, axis=-1).astype(vals.dtype)
        return jnp.einsum('bgrqk,bgkd->bgrqd', p, vals)

    o = lax.map(block, q_blocks)
    o = jnp.moveaxis(o, 0, 3).reshape(b, ATT_HEADS, n, HEAD_DIM)
    out = _merge_heads(o)
    out_c = None
    if need_ctx:
        qch = _rmsnorm(_heads(qc, ATT_HEADS), gq).reshape(b, ATT_KV_HEADS, rep, nc, HEAD_DIM)
        s = jnp.einsum('bgrqd,bgkd->bgrqk', qch, kch).astype(jnp.float32) * scale
        p = jax.nn.softmax(s, axis=-1).astype(vch.dtype)
        oc = jnp.einsum('bgrqk,bgkd->bgrqd', p, vch).reshape(b, ATT_HEADS, nc, HEAD_DIM)
        out_c = _merge_heads(oc)
    return out, out_c


def _na_mixer(q, k, v, qc, kc, vc, gq, gk, rel_bias, need_ctx):
    b, n, _ = q.shape
    rows = n // GRID_W
    kh_win = min(WIN_H, rows)
    n_loc = kh_win * WIN_W
    scale = HEAD_DIM ** -0.5
    qh = _rmsnorm(_heads(q, NA_HEADS), gq)
    kh = _rmsnorm(_heads(k, NA_HEADS), gk)
    vh = _heads(v, NA_HEADS)
    qch = _rmsnorm(_heads(qc, NA_HEADS), gq)
    kch = _rmsnorm(_heads(kc, NA_HEADS), gk)
    vch = _heads(vc, NA_HEADS)
    q_rows = jnp.moveaxis(qh.reshape(b, NA_HEADS, rows, GRID_W, HEAD_DIM), 2, 0)
    k_grid = kh.reshape(b, NA_HEADS, rows, GRID_W, HEAD_DIM)
    v_grid = vh.reshape(b, NA_HEADS, rows, GRID_W, HEAD_DIM)
    cols = jnp.arange(GRID_W)
    col_start = jnp.clip(cols - WIN_W // 2, 0, GRID_W - WIN_W)
    col_idx = col_start[:, None] + jnp.arange(WIN_W)[None, :]
    dc_idx = col_idx - cols[:, None] + (WIN_W - 1)

    def row_block(args):
        r, qr = args
        rs = jnp.clip(r - WIN_H // 2, 0, rows - kh_win)
        k_win = lax.dynamic_slice_in_dim(k_grid, rs, kh_win, axis=2)[:, :, :, col_idx]
        v_win = lax.dynamic_slice_in_dim(v_grid, rs, kh_win, axis=2)[:, :, :, col_idx]
        dr_idx = rs + jnp.arange(kh_win) - r + (WIN_H - 1)
        bias = rel_bias[:, dr_idx[None, :, None], dc_idx[:, None, :]]
        s_loc = jnp.einsum('bhqd,bhiqjd->bhqij', qr, k_win).astype(jnp.float32) * scale + bias.astype(jnp.float32)
        s_ctx = jnp.einsum('bhqd,bhkd->bhqk', qr, kch).astype(jnp.float32) * scale
        s = jnp.concatenate([s_loc.reshape(b, NA_HEADS, GRID_W, n_loc), s_ctx], axis=-1)
        p = jax.nn.softmax(s, axis=-1).astype(vh.dtype)
        p_loc = p[..., :n_loc].reshape(b, NA_HEADS, GRID_W, kh_win, WIN_W)
        return (jnp.einsum('bhqij,bhiqjd->bhqd', p_loc, v_win)
                + jnp.einsum('bhqk,bhkd->bhqd', p[..., n_loc:], vch))

    o = lax.map(row_block, (jnp.arange(rows), q_rows))
    o = jnp.moveaxis(o, 0, 2).reshape(b, NA_HEADS, n, HEAD_DIM)
    out = _merge_heads(o)
    out_c = None
    if need_ctx:
        s = jnp.einsum('bhqd,bhkd->bhqk', qch, kch).astype(jnp.float32) * scale
        p = jax.nn.softmax(s, axis=-1).astype(vch.dtype)
        out_c = _merge_heads(jnp.einsum('bhqk,bhkd->bhqd', p, vch))
    return out, out_c


def _fourier_mixer(f, w):
    b, n, _ = f.shape
    fh = f.astype(jnp.float32).reshape(b, n, FNO_HEADS, FNO_HEAD_W)
    y = jnp.fft.fftn(fh, axes=(1, 3), norm='ortho').real
    return (y.reshape(b, n, GROUP_W) @ w.astype(jnp.float32)).astype(f.dtype)


def _zoh(lam_re, lam_im, log_dt, b_re, b_im):
    lam = lax.complex(lam_re.astype(jnp.float32), lam_im.astype(jnp.float32))
    dt = jnp.exp(log_dt.astype(jnp.float32))[:, None]
    a_bar = jnp.exp(lam * dt)
    b_mat = lax.complex(b_re.astype(jnp.float32), b_im.astype(jnp.float32))
    b_bar = ((a_bar - 1.0) / lam)[..., None] * b_mat
    return a_bar, b_bar


def _diag_scan(u, a_bar, b_bar, h0, reverse):
    n = u.shape[1]
    bu = jnp.einsum('gpc,bngc->bngp', b_bar, u)
    if h0 is not None:
        edge = n - 1 if reverse else 0
        bu = bu.at[:, edge].add(a_bar * h0)
    a = jnp.broadcast_to(a_bar, (1, n) + a_bar.shape)

    def combine(e1, e2):
        a1, b1 = e1
        a2, b2 = e2
        return a1 * a2, a2 * b1 + b2

    _, h = lax.associative_scan(combine, (a, bu), axis=1, reverse=reverse)
    return h


def _glu(y, w_glu, b_glu):
    g = jax.nn.gelu(y)
    return g * jax.nn.sigmoid(g @ w_glu.astype(jnp.float32) + b_glu.astype(jnp.float32))


def _s5_mixer(u, uc, lam_re, lam_im, log_dt, b_re, b_im, c_re, c_im, d_skip, w_glu, b_glu, need_ctx):
    b, n, _ = u.shape
    nc = uc.shape[1]
    uf = u.astype(jnp.float32).reshape(b, n, SSM_GROUPS, SSM_GROUP)
    ucf = uc.astype(jnp.float32).reshape(b, nc, SSM_GROUPS, SSM_GROUP)
    d_g = d_skip.astype(jnp.float32).reshape(SSM_GROUPS, SSM_GROUP)
    y = uf * d_g
    yc = ucf * d_g
    for direction in range(2):
        reverse = direction == 1
        a_bar, b_bar = _zoh(lam_re[direction], lam_im[direction], log_dt[direction], b_re[direction], b_im[direction])
        c_mat = lax.complex(c_re[direction].astype(jnp.float32), c_im[direction].astype(jnp.float32))
        h_ctx = _diag_scan(ucf, a_bar, b_bar, None, reverse)
        h0 = h_ctx[:, 0] if reverse else h_ctx[:, -1]
        h_lat = _diag_scan(uf, a_bar, b_bar, h0, reverse)
        y = y + jnp.einsum('gcp,bngp->bngc', c_mat, h_lat).real
        if need_ctx:
            yc = yc + jnp.einsum('gcp,bngp->bngc', c_mat, h_ctx).real
    out = _glu(y.reshape(b, n, GROUP_W), w_glu, b_glu).astype(u.dtype)
    out_c = None
    if need_ctx:
        out_c = _glu(yc.reshape(b, nc, GROUP_W), w_glu, b_glu).astype(uc.dtype)
    return out, out_c


def _group_norm(o, g):
    b, n, _ = o.shape
    og = _rmsnorm(o.reshape(b, n, N_GROUPS, GROUP_W), g.reshape(N_GROUPS, GROUP_W))
    return og.reshape(b, n, D_MIX)


def _swiglu(h, w1, w3, w2):
    return (jax.nn.silu(h @ w1) * (h @ w3)) @ w2


def _layer(x, xc, c, c_ctx, rope, need_ctx, w_mod, b_mod, g_norm1, w_in, att_q_gain, att_k_gain,
           na_q_gain, na_k_gain, na_rel_bias, w_fourier, ssm_lam_re, ssm_lam_im, ssm_log_dt,
           ssm_b_re, ssm_b_im, ssm_c_re, ssm_c_im, ssm_d, w_glu, b_glu, g_group, w_out,
           g_norm2, w_ff1, w_ff3, w_ff2):
    sh1, sc1, ga1, sh2, sc2, ga2 = [m[:, None, :] for m in jnp.split(jax.nn.silu(c) @ w_mod + b_mod, N_MOD, axis=-1)]
    csh1, csc1, cga1, csh2, csc2, cga2 = jnp.split(jax.nn.silu(c_ctx) @ w_mod + b_mod, N_MOD, axis=-1)
    h = _rmsnorm(x, g_norm1) * (1.0 + sc1) + sh1
    hc = _rmsnorm(xc, g_norm1) * (1.0 + csc1) + csh1
    aq, ak, av, dq, dk, dv, fin, sin_ = _split_proj(h @ w_in)
    caq, cak, cav, cdq, cdk, cdv, cfin, csin = _split_proj(hc @ w_in)
    o_a, oc_a = _gqa_mixer(aq, ak, av, caq, cak, cav, att_q_gain, att_k_gain, rope, need_ctx)
    o_d, oc_d = _na_mixer(dq, dk, dv, cdq, cdk, cdv, na_q_gain, na_k_gain, na_rel_bias, need_ctx)
    o_f = _fourier_mixer(fin, w_fourier)
    o_s, oc_s = _s5_mixer(sin_, csin, ssm_lam_re, ssm_lam_im, ssm_log_dt, ssm_b_re, ssm_b_im,
                          ssm_c_re, ssm_c_im, ssm_d, w_glu, b_glu, need_ctx)
    o = _group_norm(jnp.concatenate([o_a, o_d, o_f, o_s.astype(o_a.dtype)], axis=-1), g_group)
    x = x + ga1 * (o @ w_out)
    h2 = _rmsnorm(x, g_norm2) * (1.0 + sc2) + sh2
    x = x + ga2 * _swiglu(h2, w_ff1, w_ff3, w_ff2)
    if need_ctx:
        oc_f = _fourier_mixer(cfin, w_fourier)
        oc = _group_norm(jnp.concatenate([oc_a, oc_d, oc_f, oc_s.astype(oc_a.dtype)], axis=-1), g_group)
        xc = xc + cga1 * (oc @ w_out)
        hc2 = _rmsnorm(xc, g_norm2) * (1.0 + csc2) + csh2
        xc = xc + cga2 * _swiglu(hc2, w_ff1, w_ff3, w_ff2)
    return x, xc


def setup_inputs(seed: int = 0) -> dict:
    key = jax.random.key(seed)
    ks = jax.random.split(key, 32)
    f32 = jnp.float32
    nrm = lambda k, s, sc: jax.random.normal(k, s, f32) * sc
    gain = lambda k, s: 1.0 + 0.02 * jax.random.normal(k, s, f32)
    lam_im0 = math.pi * jnp.arange(SSM_STATE, dtype=f32)
    return {
        'x': nrm(ks[0], (BATCH, SEQ, D_MODEL), 1.0),
        'c': nrm(ks[1], (BATCH, D_MODEL), 1.0),
        'ctx': nrm(ks[2], (BATCH, CTX_LEN, D_MODEL), 1.0),
        'c_ctx': nrm(ks[3], (D_MODEL,), 1.0),
        'w_mod': nrm(ks[4], (DEPTH, D_MODEL, N_MOD * D_MODEL), 0.5 * D_MODEL ** -0.5),
        'b_mod': nrm(ks[5], (DEPTH, N_MOD * D_MODEL), 0.02),
        'g_norm1': gain(ks[6], (DEPTH, D_MODEL)),
        'w_in': nrm(ks[7], (DEPTH, D_MODEL, IN_W), D_MODEL ** -0.5),
        'att_q_gain': gain(ks[8], (DEPTH, HEAD_DIM)),
        'att_k_gain': gain(ks[9], (DEPTH, HEAD_DIM)),
        'na_q_gain': gain(ks[10], (DEPTH, HEAD_DIM)),
        'na_k_gain': gain(ks[11], (DEPTH, HEAD_DIM)),
        'na_rel_bias': nrm(ks[12], (DEPTH, NA_HEADS, 2 * WIN_H - 1, 2 * WIN_W - 1), 0.02),
        'w_fourier': nrm(ks[13], (DEPTH, GROUP_W, GROUP_W), GROUP_W ** -0.5),
        'ssm_lam_re': -0.5 + 0.01 * jax.random.normal(ks[14], (DEPTH, 2, SSM_GROUPS, SSM_STATE), f32),
        'ssm_lam_im': lam_im0 + 0.01 * jax.random.normal(ks[15], (DEPTH, 2, SSM_GROUPS, SSM_STATE), f32),
        'ssm_log_dt': jax.random.uniform(ks[16], (DEPTH, 2, SSM_GROUPS), f32, minval=math.log(1e-3), maxval=math.log(1e-1)),
        'ssm_b_re': nrm(ks[17], (DEPTH, 2, SSM_GROUPS, SSM_STATE, SSM_GROUP), (2 * SSM_GROUP) ** -0.5),
        'ssm_b_im': nrm(ks[18], (DEPTH, 2, SSM_GROUPS, SSM_STATE, SSM_GROUP), (2 * SSM_GROUP) ** -0.5),
        'ssm_c_re': nrm(ks[19], (DEPTH, 2, SSM_GROUPS, SSM_GROUP, SSM_STATE), (2 * SSM_STATE) ** -0.5),
        'ssm_c_im': nrm(ks[20], (DEPTH, 2, SSM_GROUPS, SSM_GROUP, SSM_STATE), (2 * SSM_STATE) ** -0.5),
        'ssm_d': nrm(ks[21], (DEPTH, GROUP_W), 1.0),
        'w_glu': nrm(ks[22], (DEPTH, GROUP_W, GROUP_W), GROUP_W ** -0.5),
        'b_glu': nrm(ks[23], (DEPTH, GROUP_W), 0.02),
        'g_group': gain(ks[24], (DEPTH, D_MIX)),
        'w_out': nrm(ks[25], (DEPTH, D_MIX, D_MODEL), D_MIX ** -0.5),
        'g_norm2': gain(ks[26], (DEPTH, D_MODEL)),
        'w_ff1': nrm(ks[27], (DEPTH, D_MODEL, D_FF), D_MODEL ** -0.5),
        'w_ff3': nrm(ks[28], (DEPTH, D_MODEL, D_FF), D_MODEL ** -0.5),
        'w_ff2': nrm(ks[29], (DEPTH, D_FF, D_MODEL), D_FF ** -0.5),
    }


def reference(x, c, ctx, c_ctx, w_mod, b_mod, g_norm1, w_in, att_q_gain, att_k_gain, na_q_gain,
              na_k_gain, na_rel_bias, w_fourier, ssm_lam_re, ssm_lam_im, ssm_log_dt, ssm_b_re,
              ssm_b_im, ssm_c_re, ssm_c_im, ssm_d, w_glu, b_glu, g_group, w_out, g_norm2,
              w_ff1, w_ff3, w_ff2):
    rope = _rope_tables(x.shape[1])
    xc = ctx
    for i in range(DEPTH):
        x, xc = _layer(x, xc, c, c_ctx, rope, i < DEPTH - 1, w_mod[i], b_mod[i], g_norm1[i], w_in[i],
                       att_q_gain[i], att_k_gain[i], na_q_gain[i], na_k_gain[i], na_rel_bias[i],
                       w_fourier[i], ssm_lam_re[i], ssm_lam_im[i], ssm_log_dt[i], ssm_b_re[i],
                       ssm_b_im[i], ssm_c_re[i], ssm_c_im[i], ssm_d[i], w_glu[i], b_glu[i],
                       g_group[i], w_out[i], g_norm2[i], w_ff1[i], w_ff3[i], w_ff2[i])
    return x
```

```cpp
#include <hip/hip_runtime.h>
#include <hip/hip_bf16.h>
#include <hip/hip_cooperative_groups.h>
#include <cstdio>
namespace cg = cooperative_groups;

#define DI __device__ __forceinline__
typedef unsigned short u16;
typedef __attribute__((ext_vector_type(8))) short bf16x8;
typedef __attribute__((ext_vector_type(4))) short bf16x4;
typedef __attribute__((ext_vector_type(16))) float f32x16;
typedef __attribute__((ext_vector_type(4))) float f32x4;

#define MFMA32(a, b, c) __builtin_amdgcn_mfma_f32_32x32x16_bf16((a), (b), (c), 0, 0, 0)
#define MFMA16(a, b, c) __builtin_amdgcn_mfma_f32_16x16x32_bf16((a), (b), (c), 0, 0, 0)

#ifndef REP_MASK
#define REP_MASK 0
#endif
#define REP_SUB 15
constexpr int NT = 512;
constexpr int NW = 8;
constexpr int SEQ = 2048, DM = 1024, CL = 256, SL = 2304;
constexpr int MLAT = 32768, MCTX = 4096, MT = 36864, INW = 1792, DFF = 2816;
constexpr int LDS_BYTES = 131072;

constexpr size_t SZ_WIN = (size_t)INW * DM * 2, SZ_WOUT = (size_t)DM * DM * 2, SZ_W13 = (size_t)2 * DFF * DM * 2,
                 SZ_W2 = (size_t)DM * DFF * 2, SZ_WCOMB = 256 * 512 * 2, SZ_WGLU = 256 * 256 * 2;
constexpr size_t OFF_CTR = 0;
constexpr size_t OFF_BAR = 256;
constexpr size_t OFF_ROPE = 256 + 16384;
constexpr size_t OFF_WIN = 256 + 16384 + 8192;
constexpr size_t OFF_WOUT = OFF_WIN + 2 * SZ_WIN;
constexpr size_t OFF_W13 = OFF_WOUT + 2 * SZ_WOUT;
constexpr size_t OFF_W2 = OFF_W13 + 2 * SZ_W13;
constexpr size_t OFF_WCOMB = OFF_W2 + 2 * SZ_W2;
constexpr size_t OFF_WGLU = OFF_WCOMB + 2 * SZ_WCOMB;
constexpr size_t OFF_DFTN = OFF_WGLU + 2 * SZ_WGLU;
constexpr size_t OFF_DFTC = OFF_DFTN + (size_t)4096 * 2048 * 2;
constexpr size_t OFF_MOD = OFF_DFTC + (size_t)512 * 256 * 2;
constexpr size_t OFF_XC = OFF_MOD + (size_t)2 * 17 * 6144 * 4;
constexpr size_t OFF_H = OFF_XC + (size_t)MCTX * DM * 4;
constexpr size_t OFF_Z = OFF_H;
constexpr size_t OFF_YS = OFF_H + (size_t)MT * 512 * 2;
constexpr size_t OFF_ORAW = OFF_H + (size_t)MT * DM * 2;
constexpr size_t OFF_PROJ = OFF_ORAW + (size_t)MT * DM * 2;
constexpr size_t OFF_HID = OFF_PROJ;
constexpr size_t OFF_AQ = OFF_PROJ + (size_t)MT * INW * 2;
constexpr size_t OFF_AK = OFF_AQ + (size_t)16 * 4 * SL * 64 * 2;
constexpr size_t OFF_AVT = OFF_AK + (size_t)16 * 2 * SL * 64 * 2;
constexpr size_t OFF_DQ = OFF_AVT + (size_t)16 * 2 * SL * 64 * 2;
constexpr size_t OFF_DK = OFF_DQ + (size_t)16 * 4 * SL * 64 * 2;
constexpr size_t OFF_DVT = OFF_DK + (size_t)16 * 4 * SL * 64 * 2;
constexpr size_t OFF_FINT = OFF_DVT + (size_t)16 * 4 * SL * 64 * 2;
constexpr size_t OFF_FINTC = OFF_FINT + (size_t)16 * 256 * 2048 * 2;
constexpr size_t WS_END = OFF_FINTC + (size_t)16 * 256 * 256 * 2;
static_assert(OFF_HID + (size_t)MT * DFF * 2 <= OFF_FINT, "hidden alias overflow");
static_assert(WS_END <= (size_t)536870912, "workspace too large");

struct Params {
  const float *x, *c, *ctx, *c_ctx, *w_mod, *b_mod, *g_norm1, *w_in, *att_q_gain, *att_k_gain, *na_q_gain, *na_k_gain,
      *na_rel_bias, *w_fourier, *lam_re, *lam_im, *log_dt, *b_re, *b_im, *c_re, *c_im, *ssm_d, *w_glu, *b_glu, *g_group,
      *w_out, *g_norm2, *w_ff1, *w_ff3, *w_ff2;
  float* out;
  char* ws;
  int phase_begin, phase_end;
  int rep_mask, pad_;
};

typedef float f32x2_t __attribute__((ext_vector_type(2)));
typedef __bf16 bf16x2_t __attribute__((ext_vector_type(2)));
DI unsigned pack2(float a, float b) {
  f32x2_t v = {a, b};
  return __builtin_bit_cast(unsigned, __builtin_convertvector(v, bf16x2_t));
}
DI u16 f2bf(float x) { return (u16)(pack2(x, 0.f) & 0xffffu); }
DI float bf2f(u16 v) { return __uint_as_float(((unsigned)v) << 16); }
DI float gelu_tanh(float x) {
  float u = 0.7978845608028654f * (x + 0.044715f * x * x * x);
  return x * __builtin_amdgcn_rcpf(1.f + __expf(-2.f * u));
}
DI float sigmoidf(float x) { return __builtin_amdgcn_rcpf(1.f + __expf(-x)); }
DI int lane_l() {
  int l;
  asm volatile("v_mbcnt_lo_u32_b32 %0, -1, 0\n\tv_mbcnt_hi_u32_b32 %0, -1, %0" : "=v"(l));
  return l;
}
DI float shx(float v, int mask, int lane) { return __int_as_float(__builtin_amdgcn_ds_bpermute((lane ^ mask) << 2, __float_as_int(v))); }
template <class P> DI char* WSL(const P& p) { size_t z = 0; asm volatile("" : "+s"(z)); return p.ws + z; }
DI void lds_barrier() {
  asm volatile("s_waitcnt lgkmcnt(0)" ::: "memory");
  __builtin_amdgcn_s_barrier();
  asm volatile("" ::: "memory");
}
DI void wave_lds_sync() {
  asm volatile("s_waitcnt lgkmcnt(0)" ::: "memory");
  __builtin_amdgcn_wave_barrier();
}

enum { EPI_BF16 = 0, EPI_DFT = 1, EPI_GLU = 2, EPI_RESID = 3, EPI_SWIGLU = 4 };
struct GemmArgs {
  const void* A; int lda;
  const u16* Bt; int ldb;
  int M, N, K;
  u16* outb; int ldo;
  const float* aux0;
  const float* aux1;
  const float* src_lat; const float* src_ctx; float* dst_lat; float* dst_ctx;
  int npos;
  int skip_epi;
};


constexpr int BM = 256, BK = 64, HALF = 128, HT = HALF * BK;
DI int lds_byte(int r, int c) {
  int st = (r >> 4) * 2 + (c >> 5), rr = r & 15, cc = c & 31, ob = rr * 64 + cc * 2;
  return st * 1024 + (ob ^ (((ob >> 9) & 1) << 5));
}
DI void stage_rc(int b, int& R, int& C) {
  int st = b / 1024, sb = b % 1024, swz = sb ^ (((sb >> 9) & 1) << 5);
  R = (st >> 1) * 16 + swz / 64;
  C = (st & 1) * 32 + (swz % 64) / 2;
}

template <int EPI>
DI void epi4(const GemmArgs& g, int m, int n, f32x4 v, f32x4 v2) {
  if (EPI == EPI_BF16) {
    *(uint2*)(g.outb + (size_t)m * g.ldo + n) = make_uint2(pack2(v[0], v[1]), pack2(v[2], v[3]));
  } else if (EPI == EPI_DFT) {
    const int b = n >> 8, ch = n & 255;
    const int hn = g.npos >> 1;
    const int half = m >= hn ? 1 : 0, np = m - half * hn;
    const int rbase = g.npos == 2048 ? b * 2048 : MLAT + b * 256;
    const uint2 pv = make_uint2(pack2(v[0], v[1]), pack2(v[2], v[3]));
    u16* zb = g.outb + (size_t)rbase * 512 + ch;
    if (half == 0) {
      *(uint2*)(zb + (size_t)np * 512) = pv;
      if (np >= 1) *(uint2*)(zb + (size_t)(g.npos - np) * 512) = pv;
    } else if (np >= 1) {
      *(uint2*)(zb + (size_t)np * 512 + 256) = pv;
      *(uint2*)(zb + (size_t)(g.npos - np) * 512 + 256) = make_uint2(pack2(-v[0], -v[1]), pack2(-v[2], -v[3]));
    } else {
      *(uint2*)(zb + (size_t)hn * 512) = pv;
      *(uint2*)(zb + 256) = make_uint2(0u, 0u);
      *(uint2*)(zb + (size_t)hn * 512 + 256) = make_uint2(0u, 0u);
    }
  } else if (EPI == EPI_GLU) {
    uint2 gq = *(const uint2*)((const u16*)g.aux0 + (size_t)m * 256 + n);
    float4 bb = *(const float4*)(g.aux1 + n);
    float g0 = __uint_as_float(gq.x << 16), g1 = __uint_as_float(gq.x & 0xffff0000u), g2 = __uint_as_float(gq.y << 16), g3 = __uint_as_float(gq.y & 0xffff0000u);
    *(uint2*)(g.outb + (size_t)m * 1024 + 768 + n) =
        make_uint2(pack2(g0 * sigmoidf(v[0] + bb.x), g1 * sigmoidf(v[1] + bb.y)), pack2(g2 * sigmoidf(v[2] + bb.z), g3 * sigmoidf(v[3] + bb.w)));
  } else if (EPI == EPI_RESID) {
    const float* src; float* dst; const float* gp; size_t o;
    if (m < MLAT) { gp = g.aux0 + (size_t)(m >> 11) * 6144 + n; o = (size_t)m * 1024 + n; src = g.src_lat; dst = g.dst_lat; }
    else { gp = g.aux0 + (size_t)16 * 6144 + n; o = (size_t)(m - MLAT) * 1024 + n; src = g.src_ctx; dst = g.dst_ctx; }
    float4 gt = *(const float4*)gp, sv = *(const float4*)(src + o);
    *(float4*)(dst + o) = make_float4(sv.x + gt.x * v[0], sv.y + gt.y * v[1], sv.z + gt.z * v[2], sv.w + gt.w * v[3]);
  } else if (EPI == EPI_SWIGLU) {
    float h0 = v[0] * sigmoidf(v[0]) * v2[0], h1 = v[1] * sigmoidf(v[1]) * v2[1], h2 = v[2] * sigmoidf(v[2]) * v2[2], h3 = v[3] * sigmoidf(v[3]) * v2[3];
    *(uint2*)(g.outb + (size_t)m * DFF + n) = make_uint2(pack2(h0, h1), pack2(h2, h3));
  }
}

template <int EPI>
DI void gemm256_tile(const GemmArgs& g, int brow, int bcol, char* smem, int wid_s) {
  u16* shm = (u16*)smem;
  const u16* A = (const u16*)g.A;
  const u16* Bt = g.Bt;
  const int K = g.K;
  const int tid = ((wid_s << 6) | lane_l());
  const int wid = tid >> 6, lane = tid & 63, wr = wid >> 2, wc = wid & 3, fr = lane & 15, fq = lane >> 4;
  int sr0, sc0, sr1, sc1;
  stage_rc(tid * 16, sr0, sc0);
  stage_rc(tid * 16 + 8192, sr1, sc1);
  const size_t so0 = (size_t)sr0 * K + sc0, so1 = (size_t)sr1 * K + sc1;
#define SA(b, h) (shm + ((b) * 2 + (h)) * HT)
#define SB(b, h) (shm + (4 + (b) * 2 + (h)) * HT)
#define STAGE(P, BASE, br, kt) do { const u16* gp_ = (BASE) + (size_t)(br) * K + (size_t)(kt) * BK; \
    __builtin_amdgcn_global_load_lds((const unsigned*)(gp_ + so0), (unsigned*)((char*)(P) + tid * 16), 16, 0, 0); \
    __builtin_amdgcn_global_load_lds((const unsigned*)(gp_ + so1), (unsigned*)((char*)(P) + tid * 16 + 8192), 16, 0, 0); } while (0)
#define LDA(dst, b, h) _Pragma("unroll") for (int m = 0; m < 4; ++m) _Pragma("unroll") for (int k = 0; k < 2; ++k) \
    dst[m][k] = *reinterpret_cast<const bf16x8*>((char*)SA(b, h) + lds_byte(wr * 64 + m * 16 + fr, k * 32 + fq * 8))
#define LDB(dst, b, h) _Pragma("unroll") for (int n = 0; n < 2; ++n) _Pragma("unroll") for (int k = 0; k < 2; ++k) \
    dst[n][k] = *reinterpret_cast<const bf16x8*>((char*)SB(b, h) + lds_byte(wc * 32 + n * 16 + fr, k * 32 + fq * 8))
#define MMA(ai, bj, At_, Bt_) do { __builtin_amdgcn_s_setprio(1); \
    _Pragma("unroll") for (int m = 0; m < 4; ++m) _Pragma("unroll") for (int n = 0; n < 2; ++n) _Pragma("unroll") for (int k = 0; k < 2; ++k) \
      acc[ai][bj][m][n] = MFMA16(Bt_[n][k], At_[m][k], acc[ai][bj][m][n]); \
    __builtin_amdgcn_s_setprio(0); } while (0)
#define WAIT_V(n) asm volatile("s_waitcnt vmcnt(" #n ")" ::: "memory")
#define WAIT_L(n) asm volatile("s_waitcnt lgkmcnt(" #n ")" ::: "memory")
#define BAR __builtin_amdgcn_s_barrier()
#define SCHED __builtin_amdgcn_sched_barrier(0)
  f32x4 acc[2][2][4][2];
#pragma unroll
  for (int a = 0; a < 2; ++a)
#pragma unroll
    for (int b = 0; b < 2; ++b)
#pragma unroll
      for (int m = 0; m < 4; ++m)
#pragma unroll
        for (int n = 0; n < 2; ++n) acc[a][b][m][n] = (f32x4){0.f, 0.f, 0.f, 0.f};
  bf16x8 At[4][2], B0[2][2], B1[2][2];
  const int nt = K / BK;
  WAIT_V(0);
  STAGE(SB(0, 0), Bt, bcol, 0); STAGE(SA(0, 0), A, brow, 0);
  STAGE(SB(0, 1), Bt, bcol + HALF, 0); STAGE(SA(0, 1), A, brow + HALF, 0);
  if (wr == 1) BAR;
  WAIT_V(4); BAR;
  STAGE(SB(1, 0), Bt, bcol, 1); STAGE(SA(1, 0), A, brow, 1); STAGE(SB(1, 1), Bt, bcol + HALF, 1);
  WAIT_V(6); BAR;
  for (int t = 0; t < nt - 2; t += 2) {
    LDB(B0, 0, 0); SCHED; LDA(At, 0, 0); STAGE(SA(1, 1), A, brow + HALF, t + 1);
    WAIT_L(8); BAR; WAIT_L(0); MMA(0, 0, At, B0); BAR; SCHED;
    LDB(B1, 0, 1); STAGE(SB(0, 0), Bt, bcol, t + 2);
    BAR; WAIT_L(0); MMA(0, 1, At, B1); BAR;
    LDA(At, 0, 1); STAGE(SA(0, 0), A, brow, t + 2);
    BAR; WAIT_L(0); MMA(1, 0, At, B0); BAR; SCHED;
    STAGE(SB(0, 1), Bt, bcol + HALF, t + 2);
    WAIT_V(6); BAR; MMA(1, 1, At, B1); BAR;
    LDB(B0, 1, 0); SCHED; LDA(At, 1, 0); STAGE(SA(0, 1), A, brow + HALF, t + 2);
    WAIT_L(8); BAR; WAIT_L(0); MMA(0, 0, At, B0); BAR; SCHED;
    LDB(B1, 1, 1); STAGE(SB(1, 0), Bt, bcol, t + 3);
    BAR; WAIT_L(0); MMA(0, 1, At, B1); BAR;
    LDA(At, 1, 1); STAGE(SA(1, 0), A, brow, t + 3);
    BAR; WAIT_L(0); MMA(1, 0, At, B0); BAR; SCHED;
    STAGE(SB(1, 1), Bt, bcol + HALF, t + 3);
    WAIT_V(6); BAR; MMA(1, 1, At, B1); BAR;
  }
  { LDB(B0, 0, 0); LDA(At, 0, 0); STAGE(SA(1, 1), A, brow + HALF, nt - 1);
    BAR; WAIT_L(0); MMA(0, 0, At, B0); BAR;
    LDB(B1, 0, 1); BAR; WAIT_L(0); MMA(0, 1, At, B1); BAR;
    LDA(At, 0, 1); WAIT_V(4); BAR; WAIT_L(0); MMA(1, 0, At, B0); MMA(1, 1, At, B1); BAR; }
  { LDB(B0, 1, 0); LDA(At, 1, 0); WAIT_V(2); BAR; WAIT_L(0); MMA(0, 0, At, B0); BAR;
    LDB(B1, 1, 1); WAIT_V(0); BAR; WAIT_L(0); MMA(0, 1, At, B1); BAR;
    LDA(At, 1, 1); BAR; WAIT_L(0); MMA(1, 0, At, B0); MMA(1, 1, At, B1); BAR; }
  if (wr == 0) BAR;
  if (!g.skip_epi)
#pragma unroll
  for (int ai = 0; ai < 2; ++ai)
#pragma unroll
    for (int bj = 0; bj < 2; ++bj)
#pragma unroll
      for (int m = 0; m < 4; ++m) {
        const int row = brow + ai * HALF + wr * 64 + m * 16 + fr;
        const int cb = bcol + bj * HALF + wc * 32;
        if (EPI == EPI_SWIGLU) {
          epi4<EPI>(g, row, (cb >> 1) + 4 * fq, acc[ai][bj][m][0], acc[ai][bj][m][1]);
        } else {
          epi4<EPI>(g, row, cb + 4 * fq, acc[ai][bj][m][0], acc[ai][bj][m][0]);
          epi4<EPI>(g, row, cb + 16 + 4 * fq, acc[ai][bj][m][1], acc[ai][bj][m][1]);
        }
      }
#undef SA
#undef SB
#undef STAGE
#undef LDA
#undef LDB
#undef MMA
}

DI void tile_of(int t, int nM, int nN, int& pm, int& pn) {
  const int nwg = nM * nN;
  int wgid = t;
  { const int q = nwg / 8, r = nwg % 8, xcd = wgid % 8, off = wgid / 8; wgid = (xcd < r ? xcd * (q + 1) : r * (q + 1) + (xcd - r) * q) + off; }
  const int nig = 8 * nN, gid = wgid / nig, fm = gid * 8, gsz = min(nM - fm, 8);
  pm = fm + ((wgid % nig) % gsz);
  pn = (wgid % nig) / gsz;
}

template <int EPI>
DI void gemm_phase(const GemmArgs& g, char* smem, int wid_s) {
  const int nM = g.M >> 8, nN = g.N >> 8;
  const int total = nM * nN;
  for (int t = blockIdx.x; t < total; t += gridDim.x) {
    int pm, pn;
    tile_of(t, nM, nN, pm, pn);
    gemm256_tile<EPI>(g, pm * 256, pn * 256, smem, wid_s);
  }
}

DI void mod_item(const Params& p, int it, char* smem, int wid_s) {
  char* const ws_ = WSL(p);
  const int tid = ((wid_s << 6) | lane_l());
  const int layer = it / 96, cb = it % 96;
  float* sl = (float*)smem;
  for (int e = tid; e < 17 * 1024; e += NT) {
    int rr = e >> 10, k = e & 1023;
    float v = rr < 16 ? p.c[rr * 1024 + k] : p.c_ctx[k];
    sl[e] = v / (1.f + __expf(-v));
  }
  __syncthreads();
  const int cc = tid & 63, kq = tid >> 6;
  float acc[17];
#pragma unroll
  for (int rr = 0; rr < 17; ++rr) acc[rr] = 0.f;
  const float* w = p.w_mod + (size_t)layer * 1024 * 6144 + cb * 64 + cc;
  for (int k = kq * 128; k < kq * 128 + 128; k += 16) {
    float wv[16];
#pragma unroll
    for (int j = 0; j < 16; ++j) wv[j] = w[(size_t)(k + j) * 6144];
#pragma unroll
    for (int j4 = 0; j4 < 4; ++j4)
#pragma unroll
      for (int rr = 0; rr < 17; ++rr) {
        float4 s4 = *(const float4*)(sl + rr * 1024 + k + 4 * j4);
        acc[rr] += s4.x * wv[4 * j4] + s4.y * wv[4 * j4 + 1] + s4.z * wv[4 * j4 + 2] + s4.w * wv[4 * j4 + 3];
      }
  }
  __syncthreads();
  float* red = (float*)(smem + 17 * 1024 * 4);
#pragma unroll
  for (int rr = 0; rr < 17; ++rr) red[(kq * 17 + rr) * 64 + cc] = acc[rr];
  __syncthreads();
  float* mod = (float*)(ws_ + OFF_MOD);
  for (int e = tid; e < 17 * 64; e += NT) {
    int rr = e >> 6, c2 = e & 63;
    float s = 0.f;
#pragma unroll
    for (int q = 0; q < 8; ++q) s += red[(q * 17 + rr) * 64 + c2];
    int n = cb * 64 + c2;
    mod[(size_t)(layer * 17 + rr) * 6144 + n] = s + p.b_mod[layer * 6144 + n];
  }
  __syncthreads();
}

constexpr int T_WIN = 16 * 7, T_WOUT = 64, T_FF = 16 * 11, T_GLU = 4;
constexpr int N_TR_LAYER = T_WIN + T_WOUT + 3 * T_FF + T_GLU;

DI void transpose_item(const Params& p, int idx, char* smem, int wid_s) {
  char* const ws_ = WSL(p);
  const int tid = ((wid_s << 6) | lane_l());
  const int layer = idx / N_TR_LAYER;
  int rem = idx % N_TR_LAYER;
  const float* src; u16* dst; int K, N, mode = 0;
  if (rem < T_WIN) { src = p.w_in + (size_t)layer * DM * INW; K = DM; N = INW; dst = (u16*)(ws_ + OFF_WIN + layer * SZ_WIN); }
  else if ((rem -= T_WIN) < T_WOUT) { src = p.w_out + (size_t)layer * DM * DM; K = DM; N = DM; dst = (u16*)(ws_ + OFF_WOUT + layer * SZ_WOUT); }
  else if ((rem -= T_WOUT) < T_FF) { src = p.w_ff1 + (size_t)layer * DM * DFF; K = DM; N = DFF; dst = (u16*)(ws_ + OFF_W13 + layer * SZ_W13); mode = 1; }
  else if ((rem -= T_FF) < T_FF) { src = p.w_ff3 + (size_t)layer * DM * DFF; K = DM; N = DFF; dst = (u16*)(ws_ + OFF_W13 + layer * SZ_W13); mode = 2; }
  else if ((rem -= T_FF) < T_FF) { src = p.w_ff2 + (size_t)layer * DFF * DM; K = DFF; N = DM; dst = (u16*)(ws_ + OFF_W2 + layer * SZ_W2); }
  else { rem -= T_FF; src = p.w_glu + (size_t)layer * 256 * 256; K = 256; N = 256; dst = (u16*)(ws_ + OFF_WGLU + layer * SZ_WGLU); }
  const int tiles_n = N >> 8;
  const int tk = rem / tiles_n, tn4 = rem % tiles_n;
  float* tile = (float*)smem;
  float4 v[8];
#pragma unroll
  for (int i = 0; i < 8; ++i) {
    const int id = tid + 512 * i;
    const int k = id >> 6, n4 = id & 63;
    v[i] = *(const float4*)(src + (size_t)(tk * 64 + k) * N + tn4 * 256 + 4 * n4);
  }
#pragma unroll
  for (int i = 0; i < 8; ++i) {
    const int id = tid + 512 * i;
    const int k = id >> 6, n4 = id & 63;
    float* tp = tile + (n4 >> 4) * (64 * 65) + k * 65 + 4 * (n4 & 15);
    tp[0] = v[i].x; tp[1] = v[i].y; tp[2] = v[i].z; tp[3] = v[i].w;
  }
  __syncthreads();
  {
    const int n = tid & 63, kc = tid >> 6;
#pragma unroll
    for (int q = 0; q < 4; ++q) {
      const float* tp = tile + q * (64 * 65) + (8 * kc) * 65 + n;
      const int ng = tn4 * 256 + q * 64 + n;
      const int drow = mode == 0 ? ng : ((ng >> 4) * 32 + (ng & 15) + (mode == 2 ? 16 : 0));
      *(uint4*)(dst + (size_t)drow * K + tk * 64 + 8 * kc) =
          make_uint4(pack2(tp[0], tp[65]), pack2(tp[2 * 65], tp[3 * 65]), pack2(tp[4 * 65], tp[5 * 65]), pack2(tp[6 * 65], tp[7 * 65]));
    }
  }
  __syncthreads();
}

DI void wcomb_item(const Params& p, int idx, int wid_s) {
  char* const ws_ = WSL(p);
  const int layer = idx >> 8;
  const int t_ = ((wid_s << 6) | lane_l());
  const int kk = ((idx & 255) << 1) | (t_ >> 8), j = t_ & 255;
  const int half = kk >> 8, hh = (kk >> 6) & 3, c = kk & 63;
  const float* wf = p.w_fourier + (size_t)layer * 256 * 256 + (size_t)(hh * 64) * 256 + j;
  float s = 0.f;
  for (int c2 = 0; c2 < 64; ++c2) {
    float ang = (float)((c * c2) & 63) * (1.f / 32.f);
    float t = half ? -sinpif(ang) : cospif(ang);
    s += t * wf[(size_t)c2 * 256];
  }
  u16* dst = (u16*)(ws_ + OFF_WCOMB + layer * SZ_WCOMB);
  dst[(size_t)j * 512 + kk] = f2bf(s);
}

DI void dft_item(const Params& p, int idx, bool ctxm, int wid_s) {
  char* const ws_ = WSL(p);
  const int e8 = idx * NT + ((wid_s << 6) | lane_l());
  int m, n0, hn, mask; float inv, scale; u16* dst;
  if (!ctxm) { m = e8 >> 8; n0 = (e8 & 255) * 8; hn = 1024; mask = 2047; inv = 1.f / 1024.f; scale = 0.0027621358640099515f; dst = (u16*)(ws_ + OFF_DFTN) + (size_t)m * 2048 + n0; }
  else { m = e8 >> 5; n0 = (e8 & 31) * 8; hn = 128; mask = 255; inv = 1.f / 128.f; scale = 1.f / 128.f; dst = (u16*)(ws_ + OFF_DFTC) + (size_t)m * 256 + n0; }
  const int half = m >= hn ? 1 : 0;
  int np = m - half * hn;
  const bool use_sin = half && np >= 1;
  if (half && np == 0) np = hn;
  unsigned w[4];
#pragma unroll
  for (int j = 0; j < 4; ++j) {
    float a0 = (float)((np * (n0 + 2 * j)) & mask) * inv, a1 = (float)((np * (n0 + 2 * j + 1)) & mask) * inv;
    float v0 = (use_sin ? sinpif(a0) : cospif(a0)) * scale, v1 = (use_sin ? sinpif(a1) : cospif(a1)) * scale;
    w[j] = pack2(v0, v1);
  }
  *(uint4*)dst = make_uint4(w[0], w[1], w[2], w[3]);
}

DI void phase0(const Params& p, char* smem, int wid_s) {
  constexpr int N_MOD = 192, N_TR = 2 * N_TR_LAYER, N_WCOMB = 512, N_DFTN = 1024, N_DFTC = 16;
  constexpr int E1 = N_MOD, E2 = E1 + N_TR, E3 = E2 + N_WCOMB, E4 = E3 + N_DFTN, E5 = E4 + N_DFTC, E6 = E5 + 1;
  for (int it = blockIdx.x; it < E6; it += gridDim.x) {
    if (it < E1) mod_item(p, it, smem, wid_s);
    else if (it < E2) transpose_item(p, it - E1, smem, wid_s);
    else if (it < E3) wcomb_item(p, it - E2, wid_s);
    else if (it < E4) dft_item(p, it - E3, false, wid_s);
    else if (it < E5) dft_item(p, it - E4, true, wid_s);
    else {
      float2* rtab = (float2*)(WSL(p) + OFF_ROPE);
      for (int e = ((wid_s << 6) | lane_l()); e < 1024; e += NT) {
        const int pos = e >> 4, fi = e & 15;
        const float invf = exp2f(-(float)fi * (13.287712379549449f / 16.f)) * 0.3183098861837907f;
        const float a = (float)pos * invf;
        rtab[e] = make_float2(cospif(a), sinpif(a));
      }
    }
  }
}

DI void norm_phase(const float* xlat, const float* xctx, const float* gain, const float* modl, int sh_idx, int sc_idx,
                   u16* dst, int nrows, int wid_s) {
  const int lane = lane_l();
  const int gw = blockIdx.x * NW + wid_s, nw = gridDim.x * NW;
  const int rpw = (nrows + nw - 1) / nw;
  const int r0 = gw * rpw, r1 = min(r0 + rpw, nrows);
  if (r0 >= r1) return;
  float4 gs[4], hs[4], vn[4];
  int cur_mb = -1;
  {
    const float* src = r0 < MLAT ? xlat + (size_t)r0 * 1024 : xctx + (size_t)(r0 - MLAT) * 1024;
#pragma unroll
    for (int i = 0; i < 4; ++i) vn[i] = ((const float4*)src)[lane + 64 * i];
  }
  for (int row = r0; row < r1; ++row) {
    float4 v[4];
#pragma unroll
    for (int i = 0; i < 4; ++i) v[i] = vn[i];
    if (row + 1 < r1) {
      const int rn = row + 1;
      const float* src = rn < MLAT ? xlat + (size_t)rn * 1024 : xctx + (size_t)(rn - MLAT) * 1024;
#pragma unroll
      for (int i = 0; i < 4; ++i) vn[i] = ((const float4*)src)[lane + 64 * i];
    }
    const int mb = row < MLAT ? (row >> 11) : 16;
    if (mb != cur_mb) {
      cur_mb = mb;
      const float* sh = modl + (size_t)mb * 6144 + sh_idx * 1024;
      const float* sc = modl + (size_t)mb * 6144 + sc_idx * 1024;
#pragma unroll
      for (int i = 0; i < 4; ++i) {
        const int c4 = lane + 64 * i;
        float4 g4 = ((const float4*)gain)[c4], s4 = ((const float4*)sc)[c4];
        hs[i] = ((const float4*)sh)[c4];
        gs[i] = make_float4(g4.x * (1.f + s4.x), g4.y * (1.f + s4.y), g4.z * (1.f + s4.z), g4.w * (1.f + s4.w));
      }
    }
    float ss = 0.f;
#pragma unroll
    for (int i = 0; i < 4; ++i) ss += v[i].x * v[i].x + v[i].y * v[i].y + v[i].z * v[i].z + v[i].w * v[i].w;
#pragma unroll
    for (int o = 32; o >= 1; o >>= 1) ss += shx(ss, o, lane);
    const float rstd = rsqrtf(ss * (1.f / 1024.f) + 1e-6f);
#pragma unroll
    for (int i = 0; i < 4; ++i) {
      const int c4 = lane + 64 * i;
      float y0 = v[i].x * rstd * gs[i].x + hs[i].x;
      float y1 = v[i].y * rstd * gs[i].y + hs[i].y;
      float y2 = v[i].z * rstd * gs[i].z + hs[i].z;
      float y3 = v[i].w * rstd * gs[i].w + hs[i].w;
      *(uint2*)(dst + (size_t)row * 1024 + c4 * 4) = make_uint2(pack2(y0, y1), pack2(y2, y3));
    }
  }
}

DI void groupnorm_phase(const u16* oraw, const float* gg, u16* dst, int nrows, int wid_s) {
  const int lane = lane_l();
  const int gw = blockIdx.x * NW + wid_s, nw = gridDim.x * NW;
  const int rpw = (nrows + nw - 1) / nw;
  const int r0 = gw * rpw, r1 = min(r0 + rpw, nrows);
  if (r0 >= r1) return;
  float g[16];
#pragma unroll
  for (int j = 0; j < 4; ++j) {
    float4 t = ((const float4*)(gg + lane * 16))[j];
    g[4 * j] = t.x; g[4 * j + 1] = t.y; g[4 * j + 2] = t.z; g[4 * j + 3] = t.w;
  }
  bf16x8 an, bn;
  {
    const u16* src = oraw + (size_t)r0 * 1024 + lane * 16;
    an = *(const bf16x8*)src; bn = *(const bf16x8*)(src + 8);
  }
  for (int row = r0; row < r1; ++row) {
    bf16x8 a = an, b = bn;
    if (row + 1 < r1) {
      const u16* src = oraw + (size_t)(row + 1) * 1024 + lane * 16;
      an = *(const bf16x8*)src; bn = *(const bf16x8*)(src + 8);
    }
    float v[16];
    float ss = 0.f;
#pragma unroll
    for (int j = 0; j < 8; ++j) { v[j] = bf2f((u16)a[j]); v[8 + j] = bf2f((u16)b[j]); }
#pragma unroll
    for (int j = 0; j < 16; ++j) ss += v[j] * v[j];
#pragma unroll
    for (int o = 8; o >= 1; o >>= 1) ss += shx(ss, o, lane);
    const float rstd = rsqrtf(ss * (1.f / 256.f) + 1e-6f);
    unsigned w[8];
#pragma unroll
    for (int j = 0; j < 8; ++j) w[j] = pack2(v[2 * j] * rstd * g[2 * j], v[2 * j + 1] * rstd * g[2 * j + 1]);
    uint4* d4 = (uint4*)(dst + (size_t)row * 1024 + lane * 16);
    d4[0] = make_uint4(w[0], w[1], w[2], w[3]);
    d4[1] = make_uint4(w[4], w[5], w[6], w[7]);
  }
}

DI void prep_setup(const Params& p, int L, char* smem, int wid_s) {
  char* const ws_ = WSL(p);
  const int tid = ((wid_s << 6) | lane_l());
  float* gl = (float*)(smem + 49152);
  if (tid < 256) {
    const int kind = tid >> 6, e = tid & 63;
    const float* gn = (kind == 0 ? p.att_q_gain : kind == 1 ? p.att_k_gain : kind == 2 ? p.na_q_gain : p.na_k_gain) + L * 64;
    gl[tid] = gn[e];
  }
  const float2* rg = (const float2*)(ws_ + OFF_ROPE);
  float2* rl = (float2*)(smem + 53248);
  for (int i = tid; i < 1024; i += NT) { const int pos = i >> 4, e = i & 15; rl[e * 64 + pos] = rg[i]; }
  __syncthreads();
}

DI void prep_item(const Params& p, int L, int item, char* smem, int wid_s) {
  char* const ws_ = WSL(p);
  const int tid = ((wid_s << 6) | lane_l());
  const int b = item / 72, t = item % 72;
  const int row0 = t < 64 ? b * 2048 + 32 * t : MLAT + b * 256 + 32 * (t - 64);
  const u16* proj = (const u16*)(ws_ + OFF_PROJ);
  u16* tl = (u16*)smem;
  for (int id = tid; id < 2560; id += NT) {
    int row = id / 80, cc = id % 80;
    int scol = cc < 16 ? 384 + 8 * cc : (cc < 48 ? 1024 + 8 * (cc - 16) : 1280 + 8 * (cc - 48));
    uint4 v = *(const uint4*)(proj + (size_t)(row0 + row) * INW + scol);
    unsigned* d = (unsigned*)(tl + row * 642 + 8 * cc);
    d[0] = v.x; d[1] = v.y; d[2] = v.z; d[3] = v.w;
  }
  for (int pi = tid; pi < 448; pi += NT) {
    const int i = pi & 31, hv = pi >> 5;
    int col, kind, hd;
    if (hv < 4) { kind = 0; hd = hv; col = 64 * hd; }
    else if (hv < 6) { kind = 1; hd = hv - 4; col = 256 + 64 * hd; }
    else if (hv < 10) { kind = 2; hd = hv - 6; col = 512 + 64 * hd; }
    else { kind = 3; hd = hv - 10; col = 768 + 64 * hd; }
    const u16* src = proj + (size_t)(row0 + i) * INW + col;
    float v[64];
    float ss = 0.f;
#pragma unroll
    for (int q = 0; q < 8; ++q) {
      bf16x8 a = *(const bf16x8*)(src + 8 * q);
#pragma unroll
      for (int j = 0; j < 8; ++j) { v[8 * q + j] = bf2f((u16)a[j]); ss += v[8 * q + j] * v[8 * q + j]; }
    }
    const float rstd = rsqrtf(ss * (1.f / 64.f) + 1e-6f);
    const float4* gn4 = (const float4*)(smem + 49152) + kind * 16;
#pragma unroll
    for (int e4 = 0; e4 < 16; ++e4) {
      const float4 g4 = gn4[e4];
      v[4 * e4] *= rstd * g4.x; v[4 * e4 + 1] *= rstd * g4.y; v[4 * e4 + 2] *= rstd * g4.z; v[4 * e4 + 3] *= rstd * g4.w;
    }
    if (kind < 2 && t < 64) {
      const int n = 32 * t + i;
      const float2* rtab = (const float2*)(smem + 53248);
#pragma unroll
      for (int e = 0; e < 16; ++e) {
        const float2 tr = rtab[e * 64 + (n >> 6)], tc = rtab[e * 64 + (n & 63)];
        const float cr = tr.x, sr = tr.y, c2 = tc.x, s2 = tc.y;
        float t1 = v[e], t2 = v[16 + e];
        v[e] = t1 * cr - t2 * sr; v[16 + e] = t2 * cr + t1 * sr;
        t1 = v[32 + e]; t2 = v[48 + e];
        v[32 + e] = t1 * c2 - t2 * s2; v[48 + e] = t2 * c2 + t1 * s2;
      }
    }
    const int seqpos = 32 * t + i;
    u16* dst;
    if (kind == 0) dst = (u16*)(ws_ + OFF_AQ) + ((size_t)(b * 4 + hd) * SL + seqpos) * 64;
    else if (kind == 1) dst = (u16*)(ws_ + OFF_AK) + ((size_t)(b * 2 + hd) * SL + seqpos) * 64;
    else if (kind == 2) dst = (u16*)(ws_ + OFF_DQ) + ((size_t)(b * 4 + hd) * SL + seqpos) * 64;
    else dst = (u16*)(ws_ + OFF_DK) + ((size_t)(b * 4 + hd) * SL + seqpos) * 64;
    const int ksw = (kind & 1) ? ((seqpos >> 1) & 7) : 0;
#pragma unroll
    for (int q = 0; q < 8; ++q) {
      uint4 o4 = make_uint4(pack2(v[8 * q], v[8 * q + 1]), pack2(v[8 * q + 2], v[8 * q + 3]), pack2(v[8 * q + 4], v[8 * q + 5]), pack2(v[8 * q + 6], v[8 * q + 7]));
      *(uint4*)(dst + 8 * (q ^ ksw)) = o4;
    }
  }
  __syncthreads();
  for (int id = tid; id < 1536; id += NT) {
    int kg = id & 3, d = (id >> 2) & 63, hd6 = id >> 8;
    const u16* s = tl + (8 * kg) * 642 + hd6 * 64 + d;
    uint2 lo = make_uint2((unsigned)s[0] | ((unsigned)s[642] << 16), (unsigned)s[2 * 642] | ((unsigned)s[3 * 642] << 16));
    uint2 hi = make_uint2((unsigned)s[4 * 642] | ((unsigned)s[5 * 642] << 16), (unsigned)s[6 * 642] | ((unsigned)s[7 * 642] << 16));
    u16* dst = hd6 < 2 ? (u16*)(ws_ + OFF_AVT) + ((size_t)(b * 2 + hd6) * 72 + t) * 2048 + d * 32
                       : (u16*)(ws_ + OFF_DVT) + ((size_t)(b * 4 + hd6 - 2) * 72 + t) * 2048 + d * 32;
    const int vsw = (d >> 2) & 7;
    *(uint2*)(dst + 4 * ((2 * kg) ^ vsw)) = lo;
    *(uint2*)(dst + 4 * ((2 * kg + 1) ^ vsw)) = hi;
  }
  for (int id = tid; id < 1024; id += NT) {
    int kg = id & 3, ch = id >> 2;
    const u16* s = tl + (8 * kg) * 642 + 384 + ch;
    uint4 o4 = make_uint4((unsigned)s[0] | ((unsigned)s[642] << 16), (unsigned)s[2 * 642] | ((unsigned)s[3 * 642] << 16),
                          (unsigned)s[4 * 642] | ((unsigned)s[5 * 642] << 16), (unsigned)s[6 * 642] | ((unsigned)s[7 * 642] << 16));
    u16* dst = t < 64 ? (u16*)(ws_ + OFF_FINT) + ((size_t)(b * 256 + ch)) * 2048 + 32 * t + 8 * kg
                      : (u16*)(ws_ + OFF_FINTC) + ((size_t)(b * 256 + ch)) * 256 + 32 * (t - 64) + 8 * kg;
    *(uint4*)dst = o4;
  }
  __syncthreads();
}

template <bool NA>
DI void attn_wave(const u16* __restrict__ Q, const u16* __restrict__ Kb, const u16* __restrict__ Vt, int ta0, int ta1,
                  int tb0, int tb1, u16* __restrict__ O, const float* __restrict__ bias, int qrow, int qcol, int wid_s) {
  const int lane = ((wid_s << 6) | lane_l()) & 63, r = lane & 31, h = lane >> 5;
  bf16x8 qf[4];
#pragma unroll
  for (int s = 0; s < 4; ++s) qf[s] = *(const bf16x8*)(Q + r * 64 + 16 * s + 8 * h);
  f32x16 o0, o1;
#pragma unroll
  for (int e = 0; e < 16; ++e) { o0[e] = 0.f; o1[e] = 0.f; }
  float m_run = -1e30f, l_run = 0.f;
  const int qc = qcol + r;
  const int cs = min(max(qc - 8, 0), 48);
  for (int pass = 0; pass < 2; ++pass) {
    const int t0 = pass == 0 ? tb0 : ta0, t1 = pass == 0 ? tb1 : ta1;
    const bool masked = NA && pass == 1;
    for (int t = t0; t < t1; ++t) {
      const u16* kp = Kb + (size_t)(32 * t + r) * 64 + 8 * h;
      bf16x8 k0 = *(const bf16x8*)(kp), k1 = *(const bf16x8*)(kp + 16), k2 = *(const bf16x8*)(kp + 32), k3 = *(const bf16x8*)(kp + 48);
      const u16* vp = Vt + (size_t)t * 2048 + r * 32 + 4 * h;
      bf16x4 va0 = *(const bf16x4*)(vp), va1 = *(const bf16x4*)(vp + 8), va2 = *(const bf16x4*)(vp + 16), va3 = *(const bf16x4*)(vp + 24);
      bf16x4 vb0 = *(const bf16x4*)(vp + 1024), vb1 = *(const bf16x4*)(vp + 1032), vb2 = *(const bf16x4*)(vp + 1040), vb3 = *(const bf16x4*)(vp + 1048);
      f32x16 s;
#pragma unroll
      for (int e = 0; e < 16; ++e) s[e] = 0.f;
      s = MFMA32(k0, qf[0], s);
      s = MFMA32(k1, qf[1], s);
      s = MFMA32(k2, qf[2], s);
      s = MFMA32(k3, qf[3], s);
      float mx = -1e30f;
      bool valid[16];
#pragma unroll
      for (int e = 0; e < 16; ++e) {
        float sc = s[e] * 0.125f;
        valid[e] = true;
        if (masked) {
          const int key = (e & 3) + 8 * (e >> 2) + 4 * h;
          const int kc = (t & 1) * 32 + key, kr = t >> 1;
          valid[e] = (kc >= cs) && (kc < cs + 16);
          const int dc = min(max(kc - qc + 15, 0), 30);
          const int dr = min(max(kr - qrow + 7, 0), 14);
          sc = valid[e] ? sc + bias[dr * 31 + dc] : -1e30f;
        }
        s[e] = sc;
        mx = fmaxf(mx, sc);
      }
      mx = fmaxf(mx, shx(mx, 32, lane));
      const float m_new = fmaxf(m_run, mx);
      const float alpha = __expf(m_run - m_new);
      float ps = 0.f;
#pragma unroll
      for (int e = 0; e < 16; ++e) {
        float pe = __expf(s[e] - m_new);
        if (masked) pe = valid[e] ? pe : 0.f;
        s[e] = pe;
        ps += pe;
      }
      l_run = l_run * alpha + ps;
      m_run = m_new;
#pragma unroll
      for (int e = 0; e < 16; ++e) { o0[e] *= alpha; o1[e] *= alpha; }
      typedef unsigned u32x4_t __attribute__((ext_vector_type(4)));
      u32x4_t pw0 = {pack2(s[0], s[1]), pack2(s[2], s[3]), pack2(s[4], s[5]), pack2(s[6], s[7])};
      u32x4_t pw1 = {pack2(s[8], s[9]), pack2(s[10], s[11]), pack2(s[12], s[13]), pack2(s[14], s[15])};
      bf16x8 pf0 = __builtin_bit_cast(bf16x8, pw0), pf1 = __builtin_bit_cast(bf16x8, pw1);
      bf16x8 v00 = __builtin_shufflevector(va0, va1, 0, 1, 2, 3, 4, 5, 6, 7);
      bf16x8 v01 = __builtin_shufflevector(va2, va3, 0, 1, 2, 3, 4, 5, 6, 7);
      bf16x8 v10 = __builtin_shufflevector(vb0, vb1, 0, 1, 2, 3, 4, 5, 6, 7);
      bf16x8 v11 = __builtin_shufflevector(vb2, vb3, 0, 1, 2, 3, 4, 5, 6, 7);
      o0 = MFMA32(v00, pf0, o0);
      o0 = MFMA32(v01, pf1, o0);
      o1 = MFMA32(v10, pf0, o1);
      o1 = MFMA32(v11, pf1, o1);
    }
  }
  float l = l_run + shx(l_run, 32, lane);
  const float inv = 1.f / l;
#pragma unroll
  for (int g4 = 0; g4 < 4; ++g4) {
    uint2 w0 = make_uint2(pack2(o0[4 * g4] * inv, o0[4 * g4 + 1] * inv), pack2(o0[4 * g4 + 2] * inv, o0[4 * g4 + 3] * inv));
    uint2 w1 = make_uint2(pack2(o1[4 * g4] * inv, o1[4 * g4 + 1] * inv), pack2(o1[4 * g4 + 2] * inv, o1[4 * g4 + 3] * inv));
    *(uint2*)(O + (size_t)r * 1024 + 8 * g4 + 4 * h) = w0;
    *(uint2*)(O + (size_t)r * 1024 + 32 + 8 * g4 + 4 * h) = w1;
  }
}

template <bool NA>
DI void attn_block(const u16* __restrict__ Q, const char* __restrict__ Kg, const char* __restrict__ Vg, int sa0, int sa1,
                   int sb0, int sb1, u16* __restrict__ O, const float* __restrict__ bias, int qrow, int qcol, int rs,
                   char* smem, int wid_s) {
  const int lane = lane_l(), tid = (wid_s << 6) | lane, r = lane & 31, h = lane >> 5;
  bf16x8 qf[4];
#pragma unroll
  for (int s = 0; s < 4; ++s) qf[s] = *(const bf16x8*)(Q + r * 64 + 16 * s + 8 * h);
  f32x16 o0, o1;
#pragma unroll
  for (int e = 0; e < 16; ++e) { o0[e] = 0.f; o1[e] = 0.f; }
  float m_run = -1e30f, l_run = 0.f;
  const int qc = qcol + r;
  const int cs = min(max(qc - 8, 0), 48);
  const int nb = sb1 - sb0, ntot = nb + (sa1 - sa0);
  const float SC = 0.125f * 1.4426950408889634f, L2E = 1.4426950408889634f;
  float* btab = (float*)(smem + 41216);
  unsigned vmask = 0xffffffffu;
  if (NA) {
    for (int i2 = tid; i2 < 465; i2 += NT) btab[i2] = bias[i2] * L2E;
    vmask = 0u;
#pragma unroll
    for (int u = 0; u < 2; ++u)
#pragma unroll
      for (int e = 0; e < 16; ++e) {
        const int kc = u * 32 + (e & 3) + 8 * (e >> 2) + 4 * h;
        if (kc >= cs && kc < cs + 16) vmask |= 1u << (16 * u + e);
      }
  }
  const int lb = 15 - qc + 4 * h;
  uint4 kreg, vreg;
  {
    const int st0 = nb > 0 ? sb0 : sa0;
    kreg = *(const uint4*)(Kg + (size_t)st0 * 8192 + tid * 16);
    vreg = *(const uint4*)(Vg + (size_t)st0 * 8192 + tid * 16);
    *(uint4*)(smem + tid * 16) = kreg;
    *(uint4*)(smem + 8192 + tid * 16) = vreg;
  }
  __syncthreads();
  uint4 k2 = kreg, v2 = vreg;
  if (ntot > 1) {
    const int s1 = 1 < nb ? sb0 + 1 : sa0 + (1 - nb);
    kreg = *(const uint4*)(Kg + (size_t)s1 * 8192 + tid * 16);
    vreg = *(const uint4*)(Vg + (size_t)s1 * 8192 + tid * 16);
  }
  for (int i = 0; i < ntot; ++i) {
    const int st = i < nb ? sb0 + i : sa0 + (i - nb);
    if (i + 2 < ntot) {
      const int sn = (i + 2) < nb ? sb0 + i + 2 : sa0 + (i + 2 - nb);
      k2 = *(const uint4*)(Kg + (size_t)sn * 8192 + tid * 16);
      v2 = *(const uint4*)(Vg + (size_t)sn * 8192 + tid * 16);
    }
    const char* kb = smem + (i & 1) * 16384;
    const char* vb = kb + 8192;
    const bool masked = NA && i >= nb;
    const bool active = !masked || (st >= rs && st < rs + 8);
    if (active) {
      f32x16 sv[2];
      bf16x4 va[2][4], vb4[2][4];
#pragma unroll
      for (int u = 0; u < 2; ++u) {
        const int R = 32 * u + r;
        const char* kp = kb + R * 128;
        const int ksw = (R >> 1) & 7;
        bf16x8 k0 = *(const bf16x8*)(kp + (((0 + h) ^ ksw) << 4)), k1 = *(const bf16x8*)(kp + (((2 + h) ^ ksw) << 4));
        bf16x8 k2 = *(const bf16x8*)(kp + (((4 + h) ^ ksw) << 4)), k3 = *(const bf16x8*)(kp + (((6 + h) ^ ksw) << 4));
        f32x16 s;
#pragma unroll
        for (int e = 0; e < 16; ++e) s[e] = 0.f;
        s = MFMA32(k0, qf[0], s);
        s = MFMA32(k1, qf[1], s);
        s = MFMA32(k2, qf[2], s);
        s = MFMA32(k3, qf[3], s);
        sv[u] = s;
        const int vsw = (r >> 2) & 7;
        const char* vp = vb + u * 4096 + r * 64;
#pragma unroll
        for (int q = 0; q < 4; ++q) {
          va[u][q] = *(const bf16x4*)(vp + (((2 * q + h) ^ vsw) << 3));
          vb4[u][q] = *(const bf16x4*)(vp + 2048 + (((2 * q + h) ^ vsw) << 3));
        }
      }
      float mx = -1e30f;
      if (masked) {
#pragma unroll
        for (int u = 0; u < 2; ++u)
#pragma unroll
          for (int e = 0; e < 16; ++e) {
            const bool vld = (vmask >> (16 * u + e)) & 1u;
            const float* bp = btab + (st - qrow + 7) * 31 + lb;
            const float sc = vld ? sv[u][e] * SC + bp[32 * u + (e & 3) + 8 * (e >> 2)] : -1e30f;
            sv[u][e] = sc;
            mx = fmaxf(mx, sc);
          }
      } else {
#pragma unroll
        for (int u = 0; u < 2; ++u)
#pragma unroll
          for (int e = 0; e < 16; e += 2) mx = fmaxf(mx, fmaxf(sv[u][e], sv[u][e + 1]));
        mx *= SC;
      }
      mx = fmaxf(mx, shx(mx, 32, lane));
      const float m_new = fmaxf(m_run, mx);
      if (__any(m_new > m_run)) {
        const float alpha = __builtin_amdgcn_exp2f(m_run - m_new);
        l_run *= alpha;
        const f32x2_t al2 = {alpha, alpha};
#pragma unroll
        for (int e = 0; e < 16; e += 2) {
          f32x2_t a0 = {o0[e], o0[e + 1]}, a1 = {o1[e], o1[e + 1]};
          a0 *= al2; a1 *= al2;
          o0[e] = a0[0]; o0[e + 1] = a0[1]; o1[e] = a1[0]; o1[e + 1] = a1[1];
        }
        m_run = m_new;
      }
      f32x2_t ps2 = {0.f, 0.f};
      if (masked) {
#pragma unroll
        for (int u = 0; u < 2; ++u)
#pragma unroll
          for (int e = 0; e < 16; ++e) {
            float pe = __builtin_amdgcn_exp2f(sv[u][e] - m_run);
            pe = ((vmask >> (16 * u + e)) & 1u) ? pe : 0.f;
            sv[u][e] = pe;
            ps2[e & 1] += pe;
          }
      } else {
        const f32x2_t sc2 = {SC, SC}, nm2 = {-m_run, -m_run};
#pragma unroll
        for (int u = 0; u < 2; ++u)
#pragma unroll
          for (int e = 0; e < 16; e += 2) {
            f32x2_t x = {sv[u][e], sv[u][e + 1]};
            x = x * sc2 + nm2;
            f32x2_t pe = {__builtin_amdgcn_exp2f(x[0]), __builtin_amdgcn_exp2f(x[1])};
            sv[u][e] = pe[0]; sv[u][e + 1] = pe[1];
            ps2 += pe;
          }
      }
      l_run += ps2[0] + ps2[1];
      typedef unsigned u32x4_t __attribute__((ext_vector_type(4)));
#pragma unroll
      for (int u = 0; u < 2; ++u) {
        u32x4_t pw0 = {pack2(sv[u][0], sv[u][1]), pack2(sv[u][2], sv[u][3]), pack2(sv[u][4], sv[u][5]), pack2(sv[u][6], sv[u][7])};
        u32x4_t pw1 = {pack2(sv[u][8], sv[u][9]), pack2(sv[u][10], sv[u][11]), pack2(sv[u][12], sv[u][13]), pack2(sv[u][14], sv[u][15])};
        bf16x8 pf0 = __builtin_bit_cast(bf16x8, pw0), pf1 = __builtin_bit_cast(bf16x8, pw1);
        bf16x8 v00 = __builtin_shufflevector(va[u][0], va[u][1], 0, 1, 2, 3, 4, 5, 6, 7);
        bf16x8 v01 = __builtin_shufflevector(va[u][2], va[u][3], 0, 1, 2, 3, 4, 5, 6, 7);
        bf16x8 v10 = __builtin_shufflevector(vb4[u][0], vb4[u][1], 0, 1, 2, 3, 4, 5, 6, 7);
        bf16x8 v11 = __builtin_shufflevector(vb4[u][2], vb4[u][3], 0, 1, 2, 3, 4, 5, 6, 7);
        o0 = MFMA32(v00, pf0, o0);
        o0 = MFMA32(v01, pf1, o0);
        o1 = MFMA32(v10, pf0, o1);
        o1 = MFMA32(v11, pf1, o1);
      }
    }
    if (i + 1 < ntot) {
      char* nbuf = smem + ((i + 1) & 1) * 16384;
      *(uint4*)(nbuf + tid * 16) = kreg;
      *(uint4*)(nbuf + 8192 + tid * 16) = vreg;
    }
    lds_barrier();
    kreg = k2; vreg = v2;
  }
  __syncthreads();
  float l = l_run + shx(l_run, 32, lane);
  const float inv = 1.f / l;
#pragma unroll
  for (int g4 = 0; g4 < 4; ++g4) {
    uint2 w0 = make_uint2(pack2(o0[4 * g4] * inv, o0[4 * g4 + 1] * inv), pack2(o0[4 * g4 + 2] * inv, o0[4 * g4 + 3] * inv));
    uint2 w1 = make_uint2(pack2(o1[4 * g4] * inv, o1[4 * g4 + 1] * inv), pack2(o1[4 * g4 + 2] * inv, o1[4 * g4 + 3] * inv));
    *(uint2*)(O + (size_t)r * 1024 + 8 * g4 + 4 * h) = w0;
    *(uint2*)(O + (size_t)r * 1024 + 32 + 8 * g4 + 4 * h) = w1;
  }
}

DI void na_block(const u16* __restrict__ Qh, const char* __restrict__ Kg, const char* __restrict__ Vg, int sa0, int sa1,
                 int sb0, int sb1, u16* __restrict__ Oh, const float* __restrict__ bias, int r0, int c0, char* smem, int wid_s) {
  const int lane = lane_l(), tid = (wid_s << 6) | lane, r = lane & 31, h = lane >> 5;
  const int qrow = r0 + (r >> 4), qc = c0 + (r & 15);
  const int token = qrow * 64 + qc;
  bf16x8 qf[4];
#pragma unroll
  for (int s = 0; s < 4; ++s) qf[s] = *(const bf16x8*)(Qh + (size_t)token * 64 + 16 * s + 8 * h);
  f32x16 o0, o1;
#pragma unroll
  for (int e = 0; e < 16; ++e) { o0[e] = 0.f; o1[e] = 0.f; }
  float m_run = -1e30f, l_run = 0.f;
  const int cs = min(max(qc - 8, 0), 48);
  const int rs_l = min(max(qrow - 4, 0), 24);
  const int k0 = min(max(c0 - 8, 0), 32);
  const int wrs0 = min(max(r0 - 4, 0), 24), wrs1 = min(max(r0 - 3, 0), 24);
  const int nb = sb1 - sb0, ntot = nb + (sa1 - sa0);
  const float SC = 0.125f * 1.4426950408889634f, L2E = 1.4426950408889634f;
  float* btab = (float*)(smem + 41216);
  for (int i2 = tid; i2 < 465; i2 += NT) btab[i2] = bias[i2] * L2E;
  unsigned vmask = 0u;
#pragma unroll
  for (int e = 0; e < 16; ++e) {
    const int kc = k0 + (e & 3) + 8 * (e >> 2) + 4 * h;
    if (kc >= cs && kc < cs + 16) vmask |= 1u << e;
  }
  const int lb = 15 - qc + 4 * h + k0;
  uint4 kreg, vreg;
  {
    const int st0 = nb > 0 ? sb0 : sa0;
    kreg = *(const uint4*)(Kg + (size_t)st0 * 8192 + tid * 16);
    vreg = *(const uint4*)(Vg + (size_t)st0 * 8192 + tid * 16);
    *(uint4*)(smem + tid * 16) = kreg;
    *(uint4*)(smem + 8192 + tid * 16) = vreg;
  }
  __syncthreads();
  uint4 k2 = kreg, v2 = vreg;
  if (ntot > 1) {
    const int s1 = 1 < nb ? sb0 + 1 : sa0 + (1 - nb);
    kreg = *(const uint4*)(Kg + (size_t)s1 * 8192 + tid * 16);
    vreg = *(const uint4*)(Vg + (size_t)s1 * 8192 + tid * 16);
  }
  for (int i = 0; i < ntot; ++i) {
    const int st = i < nb ? sb0 + i : sa0 + (i - nb);
    if (i + 2 < ntot) {
      const int sn = (i + 2) < nb ? sb0 + i + 2 : sa0 + (i + 2 - nb);
      k2 = *(const uint4*)(Kg + (size_t)sn * 8192 + tid * 16);
      v2 = *(const uint4*)(Vg + (size_t)sn * 8192 + tid * 16);
    }
    const char* kb = smem + (i & 1) * 16384;
    const char* vb = kb + 8192;
    const bool masked = i >= nb;
    const bool active = !masked || (st >= wrs0 && st < wrs1 + 8);
    if (active) {
      const int nsub = masked ? 1 : 2;
      const bool rowok = st >= rs_l && st < rs_l + 8;
      for (int u = 0; u < nsub; ++u) {
        const int koff = masked ? k0 : 32 * u;
        const int R = koff + r;
        const char* kp = kb + R * 128;
        const int ksw = (R >> 1) & 7;
        bf16x8 k0f = *(const bf16x8*)(kp + (((0 + h) ^ ksw) << 4)), k1f = *(const bf16x8*)(kp + (((2 + h) ^ ksw) << 4));
        bf16x8 k2f = *(const bf16x8*)(kp + (((4 + h) ^ ksw) << 4)), k3f = *(const bf16x8*)(kp + (((6 + h) ^ ksw) << 4));
        const int vsw = (r >> 2) & 7;
        const int g0 = (koff >> 2) + h;
        bf16x4 va[4], vb4[4];
#pragma unroll
        for (int q = 0; q < 4; ++q) {
          const int g = g0 + 2 * q;
          const char* vp = vb + (g >> 3) * 4096 + r * 64 + (((g & 7) ^ vsw) << 3);
          va[q] = *(const bf16x4*)vp;
          vb4[q] = *(const bf16x4*)(vp + 2048);
        }
        f32x16 s;
#pragma unroll
        for (int e = 0; e < 16; ++e) s[e] = 0.f;
        s = MFMA32(k0f, qf[0], s);
        s = MFMA32(k1f, qf[1], s);
        s = MFMA32(k2f, qf[2], s);
        s = MFMA32(k3f, qf[3], s);
        float mx = -1e30f;
        if (masked) {
          const float* bp = btab + (st - qrow + 7) * 31 + lb;
#pragma unroll
          for (int e = 0; e < 16; ++e) {
            const bool vld = rowok && ((vmask >> e) & 1u);
            const float sc = vld ? s[e] * SC + bp[(e & 3) + 8 * (e >> 2)] : -1e30f;
            s[e] = sc;
            mx = fmaxf(mx, sc);
          }
        } else {
#pragma unroll
          for (int e = 0; e < 16; ++e) { s[e] *= SC; mx = fmaxf(mx, s[e]); }
        }
        mx = fmaxf(mx, shx(mx, 32, lane));
        const float m_new = fmaxf(m_run, mx);
        if (__any(m_new > m_run)) {
          const float alpha = __builtin_amdgcn_exp2f(m_run - m_new);
          l_run *= alpha;
#pragma unroll
          for (int e = 0; e < 16; ++e) { o0[e] *= alpha; o1[e] *= alpha; }
          m_run = m_new;
        }
        float ps = 0.f;
#pragma unroll
        for (int e = 0; e < 16; ++e) {
          float pe = __builtin_amdgcn_exp2f(s[e] - m_run);
          if (masked) pe = (rowok && ((vmask >> e) & 1u)) ? pe : 0.f;
          s[e] = pe;
          ps += pe;
        }
        l_run += ps;
        typedef unsigned u32x4_t __attribute__((ext_vector_type(4)));
        u32x4_t pw0 = {pack2(s[0], s[1]), pack2(s[2], s[3]), pack2(s[4], s[5]), pack2(s[6], s[7])};
        u32x4_t pw1 = {pack2(s[8], s[9]), pack2(s[10], s[11]), pack2(s[12], s[13]), pack2(s[14], s[15])};
        bf16x8 pf0 = __builtin_bit_cast(bf16x8, pw0), pf1 = __builtin_bit_cast(bf16x8, pw1);
        bf16x8 v00 = __builtin_shufflevector(va[0], va[1], 0, 1, 2, 3, 4, 5, 6, 7);
        bf16x8 v01 = __builtin_shufflevector(va[2], va[3], 0, 1, 2, 3, 4, 5, 6, 7);
        bf16x8 v10 = __builtin_shufflevector(vb4[0], vb4[1], 0, 1, 2, 3, 4, 5, 6, 7);
        bf16x8 v11 = __builtin_shufflevector(vb4[2], vb4[3], 0, 1, 2, 3, 4, 5, 6, 7);
        o0 = MFMA32(v00, pf0, o0);
        o0 = MFMA32(v01, pf1, o0);
        o1 = MFMA32(v10, pf0, o1);
        o1 = MFMA32(v11, pf1, o1);
      }
    }
    if (i + 1 < ntot) {
      char* nbuf = smem + ((i + 1) & 1) * 16384;
      *(uint4*)(nbuf + tid * 16) = kreg;
      *(uint4*)(nbuf + 8192 + tid * 16) = vreg;
    }
    lds_barrier();
    kreg = k2; vreg = v2;
  }
  __syncthreads();
  float l = l_run + shx(l_run, 32, lane);
  const float inv = 1.f / l;
  u16* O = Oh + (size_t)token * 1024;
#pragma unroll
  for (int g4 = 0; g4 < 4; ++g4) {
    uint2 w0 = make_uint2(pack2(o0[4 * g4] * inv, o0[4 * g4 + 1] * inv), pack2(o0[4 * g4 + 2] * inv, o0[4 * g4 + 3] * inv));
    uint2 w1 = make_uint2(pack2(o1[4 * g4] * inv, o1[4 * g4 + 1] * inv), pack2(o1[4 * g4 + 2] * inv, o1[4 * g4 + 3] * inv));
    *(uint2*)(O + 8 * g4 + 4 * h) = w0;
    *(uint2*)(O + 32 + 8 * g4 + 4 * h) = w1;
  }
}

DI void s5_wave(const Params& p, int L, int witem, bool need_ctx, char* sw, u16* ysb, int wid_s) {
  char* const ws_ = WSL(p);
  const int lane = ((wid_s << 6) | lane_l()) & 63;
  const int b = witem >> 5, g = (witem >> 1) & 15, dir = witem & 1;
  float* BU = (float*)sw;
  unsigned* HS = (unsigned*)(sw + 16 * 132 * 4);
  u16* ysd = ysb + (size_t)dir * MT * 256;
  const int pg = (L * 2 + dir) * 16 + g;
  const float dt = __expf(p.log_dt[pg]);
  float a_re, a_im;
  {
    const float lr = p.lam_re[pg * 64 + lane], li = p.lam_im[pg * 64 + lane];
    const float mag = __expf(lr * dt);
    const float ang = li * dt * 0.3183098861837907f;
    a_re = mag * cospif(ang); a_im = mag * sinpif(ang);
    const float den = 1.f / (lr * lr + li * li);
    const float f_re = ((a_re - 1.f) * lr + a_im * li) * den;
    const float f_im = (a_im * lr - (a_re - 1.f) * li) * den;
    const float* br = p.b_re + ((size_t)pg * 64 + lane) * 16;
    const float* bi = p.b_im + ((size_t)pg * 64 + lane) * 16;
#pragma unroll
    for (int c4 = 0; c4 < 4; ++c4) {
      float4 r4 = *(const float4*)(br + 4 * c4), i4 = *(const float4*)(bi + 4 * c4);
      float4 ore = make_float4(f_re * r4.x - f_im * i4.x, f_re * r4.y - f_im * i4.y, f_re * r4.z - f_im * i4.z, f_re * r4.w - f_im * i4.w);
      float4 oim = make_float4(f_re * i4.x + f_im * r4.x, f_re * i4.y + f_im * r4.y, f_re * i4.z + f_im * r4.z, f_re * i4.w + f_im * r4.w);
      *(float4*)(BU + (2 * lane) * 16 + 4 * c4) = ore;
      *(float4*)(BU + (2 * lane + 1) * 16 + 4 * c4) = oim;
    }
  }
  wave_lds_sync();
  const int l15 = lane & 15, kg = lane >> 4;
  bf16x8 bfrag[8];
#pragma unroll
  for (int nt = 0; nt < 8; ++nt) {
    const int n = 16 * nt + l15;
#pragma unroll
    for (int j = 0; j < 8; ++j) bfrag[nt][j] = 0;
    if (kg < 2) {
      float4 x0 = *(const float4*)(BU + n * 16 + 8 * kg), x1 = *(const float4*)(BU + n * 16 + 8 * kg + 4);
      bfrag[nt][0] = (short)f2bf(x0.x); bfrag[nt][1] = (short)f2bf(x0.y); bfrag[nt][2] = (short)f2bf(x0.z); bfrag[nt][3] = (short)f2bf(x0.w);
      bfrag[nt][4] = (short)f2bf(x1.x); bfrag[nt][5] = (short)f2bf(x1.y); bfrag[nt][6] = (short)f2bf(x1.z); bfrag[nt][7] = (short)f2bf(x1.w);
    }
  }
  wave_lds_sync();
  bf16x8 cfrag[4];
  {
    const float* cr = p.c_re + ((size_t)pg * 16 + l15) * 64;
    const float* ci = p.c_im + ((size_t)pg * 16 + l15) * 64;
#pragma unroll
    for (int s = 0; s < 4; ++s) {
      float4 r4 = *(const float4*)(cr + 16 * s + 4 * kg), i4 = *(const float4*)(ci + 16 * s + 4 * kg);
      cfrag[s][0] = (short)f2bf(r4.x); cfrag[s][1] = (short)f2bf(-i4.x);
      cfrag[s][2] = (short)f2bf(r4.y); cfrag[s][3] = (short)f2bf(-i4.y);
      cfrag[s][4] = (short)f2bf(r4.z); cfrag[s][5] = (short)f2bf(-i4.z);
      cfrag[s][6] = (short)f2bf(r4.w); cfrag[s][7] = (short)f2bf(-i4.w);
    }
  }
  const u16* proj = (const u16*)(ws_ + OFF_PROJ);
  auto rowof = [&](int ci_, int tt) -> int {
    if (ci_ < 16) { int q = ci_ * 16 + tt; int pos = dir ? 255 - q : q; return MLAT + b * 256 + pos; }
    int q = (ci_ - 16) * 16 + tt; int pos = dir ? 2047 - q : q; return b * 2048 + pos;
  };
  auto loadu = [&](int ci_) -> bf16x8 {
    bf16x8 u;
#pragma unroll
    for (int j = 0; j < 8; ++j) u[j] = 0;
    if (kg < 2) u = *(const bf16x8*)(proj + (size_t)rowof(ci_, l15) * INW + 1536 + 16 * g + 8 * kg);
    return u;
  };
  float h_re = 0.f, h_im = 0.f;
  bf16x8 ucur = loadu(0), un1 = loadu(1), un2 = loadu(2);
  for (int ci = 0; ci < 144; ++ci) {
    bf16x8 un3 = loadu(ci + 3 < 144 ? ci + 3 : 143);
#pragma unroll
    for (int nt = 0; nt < 8; ++nt) {
      f32x4 z = {0.f, 0.f, 0.f, 0.f};
      f32x4 a = MFMA16(bfrag[nt], ucur, z);
      *(f32x4*)(BU + l15 * 132 + 16 * nt + 4 * kg) = a;
    }
    wave_lds_sync();
    float2 bu[16];
#pragma unroll
    for (int tt = 0; tt < 16; ++tt) bu[tt] = *(const float2*)(BU + tt * 132 + 2 * lane);
    unsigned hp[16];
#pragma unroll
    for (int tt = 0; tt < 16; ++tt) {
      float nr = a_re * h_re - a_im * h_im + bu[tt].x;
      float ni = a_re * h_im + a_im * h_re + bu[tt].y;
      h_re = nr; h_im = ni;
      hp[tt] = pack2(h_re, h_im);
    }
#pragma unroll
    for (int tt = 0; tt < 16; ++tt) HS[tt * 68 + lane] = hp[tt];
    wave_lds_sync();
    if (ci >= 16 || need_ctx) {
      f32x4 y = {0.f, 0.f, 0.f, 0.f};
#pragma unroll
      for (int s = 0; s < 4; ++s) {
        bf16x8 af = *(const bf16x8*)(HS + l15 * 68 + 16 * s + 4 * kg);
        y = MFMA16(cfrag[s], af, y);
      }
      {
        const int row = rowof(ci, l15);
        *(uint2*)(ysd + (size_t)row * 256 + 16 * g + 4 * kg) = make_uint2(pack2(y[0], y[1]), pack2(y[2], y[3]));
      }
    }
    wave_lds_sync();
    ucur = un1; un1 = un2; un2 = un3;
  }
}

DI void mixers_phase(const Params& p, int L, char* smem, bool dup, int wid_s) {
  char* const ws_ = WSL(p);
  __shared__ int s_item;
  const bool need_ctx = (L == 0);
  const int tid = ((wid_s << 6) | lane_l()), wid = wid_s;
  int* ctr = (int*)(ws_ + OFF_CTR) + L + (dup ? 2 : 0);
  const int N_S5 = 64, N_DFT = 128, N_DFTC = need_ctx ? 16 : 0, N_GA = 512, N_GAC = need_ctx ? 64 : 0, N_NA = 512, N_NAC = need_ctx ? 64 : 0;
  const int E1 = N_S5, E2 = E1 + N_DFT, E3 = E2 + N_DFTC, E4 = E3 + N_GA, E5 = E4 + N_GAC, E6 = E5 + N_NA, E7 = E6 + N_NAC;
  u16* oraw = (u16*)(ws_ + OFF_ORAW);
  for (;;) {
    if (tid == 0) s_item = atomicAdd(ctr, 1);
    __syncthreads();
    const int it = s_item;
    __syncthreads();
    if (it >= E7) break;
    if (dup) {
      const int cls = it < E1 ? 1 : (it < E3 ? 2 : (it < E5 ? 4 : 8));
      if (!(REP_SUB & cls)) continue;
    }
    if (it < E1) {
      s5_wave(p, L, it * NW + wid, need_ctx, smem + wid * 12800, dup ? (u16*)p.out : (u16*)(ws_ + OFF_YS), wid_s);
    } else if (it < E2) {
      GemmArgs g{};
      g.A = ws_ + OFF_DFTN; g.Bt = (const u16*)(ws_ + OFF_FINT);
      g.M = 2048; g.N = 4096; g.K = 2048; g.outb = (u16*)(ws_ + OFF_Z); g.npos = 2048;
      int t = it - E1;
      gemm256_tile<EPI_DFT>(g, (t >> 4) * 256, (t & 15) * 256, smem, wid_s);
    } else if (it < E3) {
      GemmArgs g{};
      g.A = ws_ + OFF_DFTC; g.Bt = (const u16*)(ws_ + OFF_FINTC);
      g.M = 256; g.N = 4096; g.K = 256; g.outb = (u16*)(ws_ + OFF_Z); g.npos = 256;
      int t = it - E2;
      gemm256_tile<EPI_DFT>(g, (t >> 4) * 256, (t & 15) * 256, smem, wid_s);
    } else if (it < E4) {
      int t = it - E3;
      int qb = t & 15, kvh = (t >> 4) & 1, b = t >> 5;
      int hd = 2 * kvh + (wid >> 2);
      int q0 = qb * 128 + (wid & 3) * 32;
      const u16* Q = (const u16*)(ws_ + OFF_AQ) + ((size_t)(b * 4 + hd) * SL + q0) * 64;
      const char* K = ws_ + OFF_AK + (size_t)(b * 2 + kvh) * SL * 128;
      const char* V = ws_ + OFF_AVT + (size_t)(b * 2 + kvh) * 72 * 4096;
      attn_block<false>(Q, K, V, 0, 36, 0, 0, oraw + (size_t)(b * 2048 + q0) * 1024 + hd * 64, nullptr, 0, 0, 0, smem, wid_s);
    } else if (it < E5) {
      int t = it - E4;
      int qb = t & 1, kvh = (t >> 1) & 1, b = t >> 2;
      int hd = 2 * kvh + (wid >> 2);
      int q0 = qb * 128 + (wid & 3) * 32;
      const u16* Q = (const u16*)(ws_ + OFF_AQ) + ((size_t)(b * 4 + hd) * SL + 2048 + q0) * 64;
      const char* K = ws_ + OFF_AK + (size_t)(b * 2 + kvh) * SL * 128;
      const char* V = ws_ + OFF_AVT + (size_t)(b * 2 + kvh) * 72 * 4096;
      attn_block<false>(Q, K, V, 32, 36, 0, 0, oraw + (size_t)(MLAT + b * 256 + q0) * 1024 + hd * 64, nullptr, 0, 0, 0, smem, wid_s);
    } else if (it < E6) {
      int t = it - E5;
      int qb = t & 7, hd = (t >> 3) & 3, b = t >> 5;
      const int r0 = qb * 4 + 2 * (wid >> 2), c0 = 16 * (wid & 3);
      int rs_lo = min(max(qb * 4 - 4, 0), 24), rs_hi = min(max(qb * 4 + 3 - 4, 0), 24);
      const u16* Qh = (const u16*)(ws_ + OFF_DQ) + (size_t)(b * 4 + hd) * SL * 64;
      const char* K = ws_ + OFF_DK + (size_t)(b * 4 + hd) * SL * 128;
      const char* V = ws_ + OFF_DVT + (size_t)(b * 4 + hd) * 72 * 4096;
      const float* bias = p.na_rel_bias + (size_t)(L * 4 + hd) * 15 * 31;
      na_block(Qh, K, V, rs_lo, rs_hi + 8, 32, 36, oraw + (size_t)(b * 2048) * 1024 + 256 + hd * 64, bias, r0, c0, smem, wid_s);
    } else {
      int t = it - E6;
      int hd = t & 3, b = t >> 2;
      int q0 = wid * 32;
      const u16* Q = (const u16*)(ws_ + OFF_DQ) + ((size_t)(b * 4 + hd) * SL + 2048 + q0) * 64;
      const char* K = ws_ + OFF_DK + (size_t)(b * 4 + hd) * SL * 128;
      const char* V = ws_ + OFF_DVT + (size_t)(b * 4 + hd) * 72 * 4096;
      attn_block<false>(Q, K, V, 32, 36, 0, 0, oraw + (size_t)(MLAT + b * 256 + q0) * 1024 + 256 + hd * 64, nullptr, 0, 0, 0, smem, wid_s);
    }
  }
}

DI void gelu_convert(const Params& p, int L, int nrows, int wid_s) {
  char* const ws_ = WSL(p);
  const u16* yf = (const u16*)(ws_ + OFF_YS);
  const u16* yb = yf + (size_t)MT * 256;
  const u16* proj = (const u16*)(ws_ + OFF_PROJ);
  u16* g16 = (u16*)(ws_ + OFF_FINT);
  const size_t n4 = (size_t)nrows * 64;
  for (size_t i = (size_t)blockIdx.x * NT + ((wid_s << 6) | lane_l()); i < n4; i += (size_t)gridDim.x * NT) {
    const size_t row = i >> 6;
    const int c4 = (int)(i & 63) * 4;
    const uint2 a = ((const uint2*)yf)[i], b = ((const uint2*)yb)[i];
    const uint2 u = *(const uint2*)(proj + row * INW + 1536 + c4);
    const float4 d = *(const float4*)(p.ssm_d + L * 256 + c4);
    const float v0 = __uint_as_float(u.x << 16) * d.x + __uint_as_float(a.x << 16) + __uint_as_float(b.x << 16);
    const float v1 = __uint_as_float(u.x & 0xffff0000u) * d.y + __uint_as_float(a.x & 0xffff0000u) + __uint_as_float(b.x & 0xffff0000u);
    const float v2 = __uint_as_float(u.y << 16) * d.z + __uint_as_float(a.y << 16) + __uint_as_float(b.y << 16);
    const float v3 = __uint_as_float(u.y & 0xffff0000u) * d.w + __uint_as_float(a.y & 0xffff0000u) + __uint_as_float(b.y & 0xffff0000u);
    ((uint2*)g16)[i] = make_uint2(pack2(gelu_tanh(v0), gelu_tanh(v1)), pack2(gelu_tanh(v2), gelu_tanh(v3)));
  }
}

#define XB_TMO      128
#define XB_XCNT(j)  (256  + 64 * (j))
#define XB_XSUB(j)  (1280 + 64 * (j))
#define XB_XGEN(j)  (2304 + 64 * (j))
#define XB_TOP      3328
#define XB_TOPGEN   3392
#define XB_SPIN_CAP (1u << 20)
#define LAS __attribute__((address_space(3)))
DI unsigned xb_ld(unsigned* p) { return __hip_atomic_load(p, __ATOMIC_RELAXED, __HIP_MEMORY_SCOPE_AGENT); }
DI unsigned xb_add(unsigned* p, unsigned v) { return __hip_atomic_fetch_add(p, v, __ATOMIC_RELAXED, __HIP_MEMORY_SCOPE_AGENT); }
DI unsigned xb_xcc_id() { return (unsigned)__builtin_amdgcn_s_getreg((3 << 11) | 20) & 0xFu; }
#define XB_SPIN(cond, bar) do { unsigned _sp = 0; while (cond) { __builtin_amdgcn_s_sleep(1); \
    if ((++_sp & 255u) == 0u) { if (xb_ld(&(bar)[XB_TMO])) break; if (_sp > XB_SPIN_CAP) { atomicAdd(&(bar)[XB_TMO], 1u); break; } } } } while (0)
struct XcdBarrier { unsigned* bar; unsigned x; volatile LAS unsigned* st; };
DI void xcd_barrier_complete(unsigned* bar, unsigned x, unsigned& nloc, unsigned& nx) {
  const unsigned G = gridDim.x;
  unsigned sum, cnt, mine, sp = 0u;
  for (;;) {
    sum = 0u; cnt = 0u; mine = 0u;
#pragma unroll
    for (unsigned j = 0; j < 16; ++j) { const unsigned c = xb_ld(&bar[XB_XCNT(j)]); sum += c; cnt += (c > 0u) ? 1u : 0u; mine = (j == x) ? c : mine; }
    if (sum == G) break;
    __builtin_amdgcn_s_sleep(1);
    if ((++sp & 255u) == 0u) { if (xb_ld(&bar[XB_TMO])) break; if (sp > XB_SPIN_CAP) { atomicAdd(&bar[XB_TMO], 1u); break; } }
  }
  nloc = mine > 0u ? mine : 1u; nx = cnt > 0u ? cnt : 1u;
}
DI void xcd_barrier(const XcdBarrier& b, bool leader_thread) {
  asm volatile("s_waitcnt vmcnt(0)" ::: "memory");
  __syncthreads();
  if (leader_thread) {
    unsigned* bar = b.bar;
    __builtin_amdgcn_s_waitcnt(0);
    unsigned nloc = b.st[0], nx = b.st[1];
    if (nloc == 0u) { xcd_barrier_complete(bar, b.x, nloc, nx); b.st[0] = nloc; b.st[1] = nx; }
    const unsigned old = xb_add(&bar[XB_XSUB(b.x)], 1u);
    const unsigned gen = old / nloc;
    if (old + 1u == (gen + 1u) * nloc) {
      __builtin_amdgcn_fence(__ATOMIC_RELEASE, "agent");
      asm volatile("s_waitcnt vmcnt(0)" ::: "memory");
      const unsigned og = xb_add(&bar[XB_TOP], 1u);
      const unsigned tg = og / nx;
      if (og + 1u == (tg + 1u) * nx) xb_add(&bar[XB_TOPGEN], 1u);
      else XB_SPIN(xb_ld(&bar[XB_TOPGEN]) == tg, bar);
      __builtin_amdgcn_fence(__ATOMIC_ACQUIRE, "agent");
      xb_add(&bar[XB_XGEN(b.x)], 1u);
      asm volatile("s_waitcnt vmcnt(0)" ::: "memory");
    } else {
      XB_SPIN(xb_ld(&bar[XB_XGEN(b.x)]) == gen, bar);
      __builtin_amdgcn_fence(__ATOMIC_ACQUIRE, "agent");
      asm volatile("s_waitcnt vmcnt(0)" ::: "memory");
    }
  }
  __syncthreads();
}

__global__ void __launch_bounds__(NT, 2) mega_fwd(Params p) {
  extern __shared__ __attribute__((aligned(16))) char smem[];
  cg::grid_group grid = cg::this_grid();
  int ph = 0;
  const int wid_s = __builtin_amdgcn_readfirstlane((int)(threadIdx.x >> 6));
  __shared__ uint4 xb_words;
  if (threadIdx.x == 0) xb_words = make_uint4(0u, 0u, 0u, 0u);
  __syncthreads();
  XcdBarrier xb;
  xb.bar = (unsigned*)(p.ws + OFF_BAR); xb.x = xb_xcc_id(); xb.st = (volatile LAS unsigned*)&xb_words;
  if (threadIdx.x == 0) (void)xb_add(&xb.bar[XB_XCNT(xb.x)], 1u);
#define GSYNC() do { if (ph == 0) grid.sync(); else xcd_barrier(xb, wid_s == 0 && lane_l() == 0); } while (0)
#define PHASE_BEGIN if (ph >= p.phase_begin && ph < p.phase_end) { size_t z_ = 0; asm volatile("" : "+s"(z_)); char* w_ = p.ws + z_; const int nrep_ = 1 + ((p.rep_mask >> ph) & 1); for (int rep_ = 0; rep_ < nrep_; ++rep_) { const bool dup = rep_ > 0; (void)dup;
#define PHASE_END   if (rep_ + 1 < nrep_) GSYNC(); } if (ph + 1 < p.phase_end) GSYNC(); } ++ph;

  PHASE_BEGIN phase0(p, smem, wid_s); PHASE_END

#define mod ((float*)(w_ + OFF_MOD))
#define xc ((float*)(w_ + OFF_XC))
#define modl (mod + (size_t)L * 17 * 6144)
  for (int L = 0; L < 2; ++L) {
    const bool need_ctx = (L == 0);
    const int mrows = need_ctx ? MT : MLAT;
    PHASE_BEGIN
      norm_phase(L == 0 ? p.x : p.out, L == 0 ? p.ctx : xc, p.g_norm1 + L * 1024, modl, 0, 1, (u16*)(w_ + OFF_H), MT, wid_s);
    PHASE_END
    PHASE_BEGIN
      GemmArgs g{};
      g.A = w_ + OFF_H; g.Bt = (const u16*)(w_ + OFF_WIN + L * SZ_WIN);
      g.M = MT; g.N = INW; g.K = DM; g.outb = (u16*)(w_ + OFF_PROJ); g.ldo = INW;
      gemm_phase<EPI_BF16>(g, smem, wid_s);
    PHASE_END
    PHASE_BEGIN
      prep_setup(p, L, smem, wid_s);
      for (int it = blockIdx.x; it < 16 * 72; it += gridDim.x) prep_item(p, L, it, smem, wid_s);
    PHASE_END
    PHASE_BEGIN mixers_phase(p, L, smem, dup, wid_s); PHASE_END
    PHASE_BEGIN
      {
        GemmArgs g{};
        g.A = w_ + OFF_Z; g.Bt = (const u16*)(w_ + OFF_WCOMB + L * SZ_WCOMB);
        g.M = mrows; g.N = 256; g.K = 512; g.outb = (u16*)(w_ + OFF_ORAW) + 512; g.ldo = 1024;
        gemm_phase<EPI_BF16>(g, smem, wid_s);
      }
      gelu_convert(p, L, mrows, wid_s);
    PHASE_END
    PHASE_BEGIN
      GemmArgs g{};
      g.A = w_ + OFF_FINT; g.Bt = (const u16*)(w_ + OFF_WGLU + L * SZ_WGLU);
      g.M = mrows; g.N = 256; g.K = 256; g.outb = (u16*)(w_ + OFF_ORAW);
      g.aux0 = (const float*)(w_ + OFF_FINT); g.aux1 = p.b_glu + L * 256;
      gemm_phase<EPI_GLU>(g, smem, wid_s);
    PHASE_END
    PHASE_BEGIN
      groupnorm_phase((const u16*)(w_ + OFF_ORAW), p.g_group + L * 1024, (u16*)(w_ + OFF_H), mrows, wid_s);
    PHASE_END
    PHASE_BEGIN
      GemmArgs g{};
      g.A = w_ + OFF_H; g.Bt = (const u16*)(w_ + OFF_WOUT + L * SZ_WOUT);
      g.M = mrows; g.N = DM; g.K = DM;
      g.aux0 = modl + 2 * 1024;
      g.src_lat = L == 0 ? p.x : p.out; g.src_ctx = p.ctx; g.dst_lat = p.out; g.dst_ctx = xc;
      gemm_phase<EPI_RESID>(g, smem, wid_s);
    PHASE_END
    PHASE_BEGIN
      norm_phase(p.out, xc, p.g_norm2 + L * 1024, modl, 3, 4, (u16*)(w_ + OFF_H), mrows, wid_s);
    PHASE_END
    PHASE_BEGIN
      GemmArgs g{};
      g.A = w_ + OFF_H; g.Bt = (const u16*)(w_ + OFF_W13 + L * SZ_W13);
      g.M = mrows; g.N = 2 * DFF; g.K = DM; g.outb = (u16*)(w_ + OFF_HID); g.skip_epi = dup ? 1 : 0;
      gemm_phase<EPI_SWIGLU>(g, smem, wid_s);
    PHASE_END
    PHASE_BEGIN
      GemmArgs g{};
      g.A = w_ + OFF_HID; g.Bt = (const u16*)(w_ + OFF_W2 + L * SZ_W2);
      g.M = mrows; g.N = DM; g.K = DFF;
      g.aux0 = modl + 5 * 1024;
      g.src_lat = p.out; g.src_ctx = xc; g.dst_lat = dup ? (float*)(w_ + OFF_H) : p.out; g.dst_ctx = dup ? (float*)(w_ + OFF_H) + (size_t)MLAT * 1024 : xc;
      gemm_phase<EPI_RESID>(g, smem, wid_s);
    PHASE_END
  }
}

#undef mod
#undef xc
#undef modl
extern "C" void kernel_launch(void* const* d_in, const int* in_sizes, int n_in, void* d_out, int out_size, void* d_ws,
                              size_t ws_size, hipStream_t stream) {
  static int grid_blocks = 0;
  if (!grid_blocks) {
    int dev = 0, cus = 0, per_cu = 0;
    (void)hipGetDevice(&dev);
    (void)hipDeviceGetAttribute(&cus, hipDeviceAttributeMultiprocessorCount, dev);
    (void)hipFuncSetAttribute((const void*)mega_fwd, hipFuncAttributeMaxDynamicSharedMemorySize, LDS_BYTES);
    (void)hipOccupancyMaxActiveBlocksPerMultiprocessor(&per_cu, (const void*)mega_fwd, NT, LDS_BYTES);
    if (per_cu < 1) per_cu = 1;
    if (per_cu > 1) per_cu = 1;
    grid_blocks = cus * per_cu;
    if (ws_size < WS_END) fprintf(stderr, "workspace too small: %zu < %zu\n", ws_size, (size_t)WS_END);
  }
  Params p{};
  const float** pp = (const float**)&p;
  for (int i = 0; i < 30; ++i) pp[i] = (const float*)d_in[i];
  p.out = (float*)d_out;
  p.ws = (char*)d_ws;
  p.phase_begin = 0;
  p.phase_end = 23;
  p.rep_mask = REP_MASK;
  (void)hipMemsetAsync((char*)d_ws + OFF_CTR, 0, 256 + 16384, stream);
  void* args[] = {&p};
  hipError_t e = hipLaunchCooperativeKernel((void*)mega_fwd, dim3(grid_blocks), dim3(NT), args, LDS_BYTES, stream);
  if (e != hipSuccess) fprintf(stderr, "cooperative launch failed: %s (grid %d)\n", hipGetErrorString(e), grid_blocks);
}
```

```cpp
#include <hip/hip_runtime.h>
#include <hip/hip_bf16.h>
#include <hip/hip_cooperative_groups.h>
#include <cstdio>
namespace cg = cooperative_groups;

#define DI __device__ __forceinline__
typedef unsigned short u16;
typedef __attribute__((ext_vector_type(8))) short bf16x8;
typedef __attribute__((ext_vector_type(4))) short bf16x4;
typedef __attribute__((ext_vector_type(16))) float f32x16;
typedef __attribute__((ext_vector_type(4))) float f32x4;

#define MFMA32(a, b, c) __builtin_amdgcn_mfma_f32_32x32x16_bf16((a), (b), (c), 0, 0, 0)
#define MFMA16(a, b, c) __builtin_amdgcn_mfma_f32_16x16x32_bf16((a), (b), (c), 0, 0, 0)

#ifndef REP_MASK
#define REP_MASK 0
#endif
#define REP_SUB 15
constexpr int NT = 512;
constexpr int NW = 8;
constexpr int SEQ = 2048, DM = 1024, CL = 256, SL = 2304;
constexpr int MLAT = 32768, MCTX = 4096, MT = 36864, INW = 1792, DFF = 2816;
constexpr int LDS_BYTES = 131072;

constexpr size_t SZ_WIN = (size_t)INW * DM * 2, SZ_WOUT = (size_t)DM * DM * 2, SZ_W13 = (size_t)2 * DFF * DM * 2,
                 SZ_W2 = (size_t)DM * DFF * 2, SZ_WCOMB = 256 * 512 * 2, SZ_WGLU = 256 * 256 * 2;
constexpr size_t OFF_CTR = 0;
constexpr size_t OFF_BAR = 256;
constexpr size_t OFF_ROPE = 256 + 16384;
constexpr size_t OFF_WIN = 256 + 16384 + 8192;
constexpr size_t OFF_WOUT = OFF_WIN + 2 * SZ_WIN;
constexpr size_t OFF_W13 = OFF_WOUT + 2 * SZ_WOUT;
constexpr size_t OFF_W2 = OFF_W13 + 2 * SZ_W13;
constexpr size_t OFF_WCOMB = OFF_W2 + 2 * SZ_W2;
constexpr size_t OFF_WGLU = OFF_WCOMB + 2 * SZ_WCOMB;
constexpr size_t OFF_DFTN = OFF_WGLU + 2 * SZ_WGLU;
constexpr size_t OFF_DFTC = OFF_DFTN + (size_t)4096 * 2048 * 2;
constexpr size_t OFF_MOD = OFF_DFTC + (size_t)512 * 256 * 2;
constexpr size_t OFF_XC = OFF_MOD + (size_t)2 * 17 * 6144 * 4;
constexpr size_t OFF_H = OFF_XC + (size_t)MCTX * DM * 4;
constexpr size_t OFF_Z = OFF_H;
constexpr size_t OFF_YS = OFF_H + (size_t)MT * 512 * 2;
constexpr size_t OFF_ORAW = OFF_H + (size_t)MT * DM * 2;
constexpr size_t OFF_PROJ = OFF_ORAW + (size_t)MT * DM * 2;
constexpr size_t OFF_HID = OFF_PROJ;
constexpr size_t OFF_AQ = OFF_PROJ + (size_t)MT * INW * 2;
constexpr size_t OFF_AK = OFF_AQ + (size_t)16 * 4 * SL * 64 * 2;
constexpr size_t OFF_AVT = OFF_AK + (size_t)16 * 2 * SL * 64 * 2;
constexpr size_t OFF_DQ = OFF_AVT + (size_t)16 * 2 * SL * 64 * 2;
constexpr size_t OFF_DK = OFF_DQ + (size_t)16 * 4 * SL * 64 * 2;
constexpr size_t OFF_DVT = OFF_DK + (size_t)16 * 4 * SL * 64 * 2;
constexpr size_t OFF_FINT = OFF_DVT + (size_t)16 * 4 * SL * 64 * 2;
constexpr size_t OFF_FINTC = OFF_FINT + (size_t)16 * 256 * 2048 * 2;
constexpr size_t WS_END = OFF_FINTC + (size_t)16 * 256 * 256 * 2;
static_assert(OFF_HID + (size_t)MT * DFF * 2 <= OFF_FINT, "hidden alias overflow");
static_assert(WS_END <= (size_t)536870912, "workspace too large");

struct Params {
  const float *x, *c, *ctx, *c_ctx, *w_mod, *b_mod, *g_norm1, *w_in, *att_q_gain, *att_k_gain, *na_q_gain, *na_k_gain,
      *na_rel_bias, *w_fourier, *lam_re, *lam_im, *log_dt, *b_re, *b_im, *c_re, *c_im, *ssm_d, *w_glu, *b_glu, *g_group,
      *w_out, *g_norm2, *w_ff1, *w_ff3, *w_ff2;
  float* out;
  char* ws;
  int phase_begin, phase_end;
  int rep_mask, pad_;
};

typedef float f32x2_t __attribute__((ext_vector_type(2)));
typedef __bf16 bf16x2_t __attribute__((ext_vector_type(2)));
DI unsigned pack2(float a, float b) {
  f32x2_t v = {a, b};
  return __builtin_bit_cast(unsigned, __builtin_convertvector(v, bf16x2_t));
}
DI u16 f2bf(float x) { return (u16)(pack2(x, 0.f) & 0xffffu); }
DI float bf2f(u16 v) { return __uint_as_float(((unsigned)v) << 16); }
DI float gelu_tanh(float x) {
  float u = 0.7978845608028654f * (x + 0.044715f * x * x * x);
  return x * __builtin_amdgcn_rcpf(1.f + __expf(-2.f * u));
}
DI float sigmoidf(float x) { return __builtin_amdgcn_rcpf(1.f + __expf(-x)); }
DI int lane_l() {
  int l;
  asm volatile("v_mbcnt_lo_u32_b32 %0, -1, 0\n\tv_mbcnt_hi_u32_b32 %0, -1, %0" : "=v"(l));
  return l;
}
DI float shx(float v, int mask, int lane) { return __int_as_float(__builtin_amdgcn_ds_bpermute((lane ^ mask) << 2, __float_as_int(v))); }
template <class P> DI char* WSL(const P& p) { size_t z = 0; asm volatile("" : "+s"(z)); return p.ws + z; }
DI void lds_barrier() {
  asm volatile("s_waitcnt lgkmcnt(0)" ::: "memory");
  __builtin_amdgcn_s_barrier();
  asm volatile("" ::: "memory");
}
DI void wave_lds_sync() {
  asm volatile("s_waitcnt lgkmcnt(0)" ::: "memory");
  __builtin_amdgcn_wave_barrier();
}

enum { EPI_BF16 = 0, EPI_DFT = 1, EPI_GLU = 2, EPI_RESID = 3, EPI_SWIGLU = 4 };
struct GemmArgs {
  const void* A; int lda;
  const u16* Bt; int ldb;
  int M, N, K;
  u16* outb; int ldo;
  const float* aux0;
  const float* aux1;
  const float* src_lat; const float* src_ctx; float* dst_lat; float* dst_ctx;
  int npos;
  int skip_epi;
};


constexpr int BM = 256, BK = 64, HALF = 128, HT = HALF * BK;
DI int lds_byte(int r, int c) {
  int st = (r >> 4) * 2 + (c >> 5), rr = r & 15, cc = c & 31, ob = rr * 64 + cc * 2;
  return st * 1024 + (ob ^ (((ob >> 9) & 1) << 5));
}
DI void stage_rc(int b, int& R, int& C) {
  int st = b / 1024, sb = b % 1024, swz = sb ^ (((sb >> 9) & 1) << 5);
  R = (st >> 1) * 16 + swz / 64;
  C = (st & 1) * 32 + (swz % 64) / 2;
}

template <int EPI>
DI void epi4(const GemmArgs& g, int m, int n, f32x4 v, f32x4 v2) {
  if (EPI == EPI_BF16) {
    *(uint2*)(g.outb + (size_t)m * g.ldo + n) = make_uint2(pack2(v[0], v[1]), pack2(v[2], v[3]));
  } else if (EPI == EPI_DFT) {
    const int b = n >> 8, ch = n & 255;
    const int hn = g.npos >> 1;
    const int half = m >= hn ? 1 : 0, np = m - half * hn;
    const int rbase = g.npos == 2048 ? b * 2048 : MLAT + b * 256;
    const uint2 pv = make_uint2(pack2(v[0], v[1]), pack2(v[2], v[3]));
    u16* zb = g.outb + (size_t)rbase * 512 + ch;
    if (half == 0) {
      *(uint2*)(zb + (size_t)np * 512) = pv;
      if (np >= 1) *(uint2*)(zb + (size_t)(g.npos - np) * 512) = pv;
    } else if (np >= 1) {
      *(uint2*)(zb + (size_t)np * 512 + 256) = pv;
      *(uint2*)(zb + (size_t)(g.npos - np) * 512 + 256) = make_uint2(pack2(-v[0], -v[1]), pack2(-v[2], -v[3]));
    } else {
      *(uint2*)(zb + (size_t)hn * 512) = pv;
      *(uint2*)(zb + 256) = make_uint2(0u, 0u);
      *(uint2*)(zb + (size_t)hn * 512 + 256) = make_uint2(0u, 0u);
    }
  } else if (EPI == EPI_GLU) {
    uint2 gq = *(const uint2*)((const u16*)g.aux0 + (size_t)m * 256 + n);
    float4 bb = *(const float4*)(g.aux1 + n);
    float g0 = __uint_as_float(gq.x << 16), g1 = __uint_as_float(gq.x & 0xffff0000u), g2 = __uint_as_float(gq.y << 16), g3 = __uint_as_float(gq.y & 0xffff0000u);
    *(uint2*)(g.outb + (size_t)m * 1024 + 768 + n) =
        make_uint2(pack2(g0 * sigmoidf(v[0] + bb.x), g1 * sigmoidf(v[1] + bb.y)), pack2(g2 * sigmoidf(v[2] + bb.z), g3 * sigmoidf(v[3] + bb.w)));
  } else if (EPI == EPI_RESID) {
    const float* src; float* dst; const float* gp; size_t o;
    if (m < MLAT) { gp = g.aux0 + (size_t)(m >> 11) * 6144 + n; o = (size_t)m * 1024 + n; src = g.src_lat; dst = g.dst_lat; }
    else { gp = g.aux0 + (size_t)16 * 6144 + n; o = (size_t)(m - MLAT) * 1024 + n; src = g.src_ctx; dst = g.dst_ctx; }
    float4 gt = *(const float4*)gp, sv = *(const float4*)(src + o);
    *(float4*)(dst + o) = make_float4(sv.x + gt.x * v[0], sv.y + gt.y * v[1], sv.z + gt.z * v[2], sv.w + gt.w * v[3]);
  } else if (EPI == EPI_SWIGLU) {
    float h0 = v[0] * sigmoidf(v[0]) * v2[0], h1 = v[1] * sigmoidf(v[1]) * v2[1], h2 = v[2] * sigmoidf(v[2]) * v2[2], h3 = v[3] * sigmoidf(v[3]) * v2[3];
    *(uint2*)(g.outb + (size_t)m * DFF + n) = make_uint2(pack2(h0, h1), pack2(h2, h3));
  }
}

template <int EPI>
DI void gemm256_tile(const GemmArgs& g, int brow, int bcol, char* smem, int wid_s) {
  u16* shm = (u16*)smem;
  const u16* A = (const u16*)g.A;
  const u16* Bt = g.Bt;
  const int K = g.K;
  const int tid = ((wid_s << 6) | lane_l());
  const int wid = tid >> 6, lane = tid & 63, wr = wid >> 2, wc = wid & 3, fr = lane & 15, fq = lane >> 4;
  int sr0, sc0, sr1, sc1;
  stage_rc(tid * 16, sr0, sc0);
  stage_rc(tid * 16 + 8192, sr1, sc1);
  const size_t so0 = (size_t)sr0 * K + sc0, so1 = (size_t)sr1 * K + sc1;
#define SA(b, h) (shm + ((b) * 2 + (h)) * HT)
#define SB(b, h) (shm + (4 + (b) * 2 + (h)) * HT)
#define STAGE(P, BASE, br, kt) do { const u16* gp_ = (BASE) + (size_t)(br) * K + (size_t)(kt) * BK; \
    __builtin_amdgcn_global_load_lds((const unsigned*)(gp_ + so0), (unsigned*)((char*)(P) + tid * 16), 16, 0, 0); \
    __builtin_amdgcn_global_load_lds((const unsigned*)(gp_ + so1), (unsigned*)((char*)(P) + tid * 16 + 8192), 16, 0, 0); } while (0)
#define LDA(dst, b, h) _Pragma("unroll") for (int m = 0; m < 4; ++m) _Pragma("unroll") for (int k = 0; k < 2; ++k) \
    dst[m][k] = *reinterpret_cast<const bf16x8*>((char*)SA(b, h) + lds_byte(wr * 64 + m * 16 + fr, k * 32 + fq * 8))
#define LDB(dst, b, h) _Pragma("unroll") for (int n = 0; n < 2; ++n) _Pragma("unroll") for (int k = 0; k < 2; ++k) \
    dst[n][k] = *reinterpret_cast<const bf16x8*>((char*)SB(b, h) + lds_byte(wc * 32 + n * 16 + fr, k * 32 + fq * 8))
#define MMA(ai, bj, At_, Bt_) do { __builtin_amdgcn_s_setprio(1); \
    _Pragma("unroll") for (int m = 0; m < 4; ++m) _Pragma("unroll") for (int n = 0; n < 2; ++n) _Pragma("unroll") for (int k = 0; k < 2; ++k) \
      acc[ai][bj][m][n] = MFMA16(Bt_[n][k], At_[m][k], acc[ai][bj][m][n]); \
    __builtin_amdgcn_s_setprio(0); } while (0)
#define WAIT_V(n) asm volatile("s_waitcnt vmcnt(" #n ")" ::: "memory")
#define WAIT_L(n) asm volatile("s_waitcnt lgkmcnt(" #n ")" ::: "memory")
#define BAR __builtin_amdgcn_s_barrier()
#define SCHED __builtin_amdgcn_sched_barrier(0)
  f32x4 acc[2][2][4][2];
#pragma unroll
  for (int a = 0; a < 2; ++a)
#pragma unroll
    for (int b = 0; b < 2; ++b)
#pragma unroll
      for (int m = 0; m < 4; ++m)
#pragma unroll
        for (int n = 0; n < 2; ++n) acc[a][b][m][n] = (f32x4){0.f, 0.f, 0.f, 0.f};
  bf16x8 At[4][2], B0[2][2], B1[2][2];
  const int nt = K / BK;
  WAIT_V(0);
  STAGE(SB(0, 0), Bt, bcol, 0); STAGE(SA(0, 0), A, brow, 0);
  STAGE(SB(0, 1), Bt, bcol + HALF, 0); STAGE(SA(0, 1), A, brow + HALF, 0);
  if (wr == 1) BAR;
  WAIT_V(4); BAR;
  STAGE(SB(1, 0), Bt, bcol, 1); STAGE(SA(1, 0), A, brow, 1); STAGE(SB(1, 1), Bt, bcol + HALF, 1);
  WAIT_V(6); BAR;
  for (int t = 0; t < nt - 2; t += 2) {
    LDB(B0, 0, 0); SCHED; LDA(At, 0, 0); STAGE(SA(1, 1), A, brow + HALF, t + 1);
    WAIT_L(8); BAR; WAIT_L(0); MMA(0, 0, At, B0); BAR; SCHED;
    LDB(B1, 0, 1); STAGE(SB(0, 0), Bt, bcol, t + 2);
    BAR; WAIT_L(0); MMA(0, 1, At, B1); BAR;
    LDA(At, 0, 1); STAGE(SA(0, 0), A, brow, t + 2);
    BAR; WAIT_L(0); MMA(1, 0, At, B0); BAR; SCHED;
    STAGE(SB(0, 1), Bt, bcol + HALF, t + 2);
    WAIT_V(6); BAR; MMA(1, 1, At, B1); BAR;
    LDB(B0, 1, 0); SCHED; LDA(At, 1, 0); STAGE(SA(0, 1), A, brow + HALF, t + 2);
    WAIT_L(8); BAR; WAIT_L(0); MMA(0, 0, At, B0); BAR; SCHED;
    LDB(B1, 1, 1); STAGE(SB(1, 0), Bt, bcol, t + 3);
    BAR; WAIT_L(0); MMA(0, 1, At, B1); BAR;
    LDA(At, 1, 1); STAGE(SA(1, 0), A, brow, t + 3);
    BAR; WAIT_L(0); MMA(1, 0, At, B0); BAR; SCHED;
    STAGE(SB(1, 1), Bt, bcol + HALF, t + 3);
    WAIT_V(6); BAR; MMA(1, 1, At, B1); BAR;
  }
  { LDB(B0, 0, 0); LDA(At, 0, 0); STAGE(SA(1, 1), A, brow + HALF, nt - 1);
    BAR; WAIT_L(0); MMA(0, 0, At, B0); BAR;
    LDB(B1, 0, 1); BAR; WAIT_L(0); MMA(0, 1, At, B1); BAR;
    LDA(At, 0, 1); WAIT_V(4); BAR; WAIT_L(0); MMA(1, 0, At, B0); MMA(1, 1, At, B1); BAR; }
  { LDB(B0, 1, 0); LDA(At, 1, 0); WAIT_V(2); BAR; WAIT_L(0); MMA(0, 0, At, B0); BAR;
    LDB(B1, 1, 1); WAIT_V(0); BAR; WAIT_L(0); MMA(0, 1, At, B1); BAR;
    LDA(At, 1, 1); BAR; WAIT_L(0); MMA(1, 0, At, B0); MMA(1, 1, At, B1); BAR; }
  if (wr == 0) BAR;
  if (!g.skip_epi)
#pragma unroll
  for (int ai = 0; ai < 2; ++ai)
#pragma unroll
    for (int bj = 0; bj < 2; ++bj)
#pragma unroll
      for (int m = 0; m < 4; ++m) {
        const int row = brow + ai * HALF + wr * 64 + m * 16 + fr;
        const int cb = bcol + bj * HALF + wc * 32;
        if (EPI == EPI_SWIGLU) {
          epi4<EPI>(g, row, (cb >> 1) + 4 * fq, acc[ai][bj][m][0], acc[ai][bj][m][1]);
        } else {
          epi4<EPI>(g, row, cb + 4 * fq, acc[ai][bj][m][0], acc[ai][bj][m][0]);
          epi4<EPI>(g, row, cb + 16 + 4 * fq, acc[ai][bj][m][1], acc[ai][bj][m][1]);
        }
      }
#undef SA
#undef SB
#undef STAGE
#undef LDA
#undef LDB
#undef MMA
}

DI void tile_of(int t, int nM, int nN, int& pm, int& pn) {
  const int nwg = nM * nN;
  int wgid = t;
  { const int q = nwg / 8, r = nwg % 8, xcd = wgid % 8, off = wgid / 8; wgid = (xcd < r ? xcd * (q + 1) : r * (q + 1) + (xcd - r) * q) + off; }
  const int nig = 8 * nN, gid = wgid / nig, fm = gid * 8, gsz = min(nM - fm, 8);
  pm = fm + ((wgid % nig) % gsz);
  pn = (wgid % nig) / gsz;
}

template <int EPI>
DI void gemm_phase(const GemmArgs& g, char* smem, int wid_s) {
  const int nM = g.M >> 8, nN = g.N >> 8;
  const int total = nM * nN;
  for (int t = blockIdx.x; t < total; t += gridDim.x) {
    int pm, pn;
    tile_of(t, nM, nN, pm, pn);
    gemm256_tile<EPI>(g, pm * 256, pn * 256, smem, wid_s);
  }
}

DI void mod_item(const Params& p, int it, char* smem, int wid_s) {
  char* const ws_ = WSL(p);
  const int tid = ((wid_s << 6) | lane_l());
  const int layer = it / 96, cb = it % 96;
  float* sl = (float*)smem;
  for (int e = tid; e < 17 * 1024; e += NT) {
    int rr = e >> 10, k = e & 1023;
    float v = rr < 16 ? p.c[rr * 1024 + k] : p.c_ctx[k];
    sl[e] = v / (1.f + __expf(-v));
  }
  __syncthreads();
  const int cc = tid & 63, kq = tid >> 6;
  float acc[17];
#pragma unroll
  for (int rr = 0; rr < 17; ++rr) acc[rr] = 0.f;
  const float* w = p.w_mod + (size_t)layer * 1024 * 6144 + cb * 64 + cc;
  for (int k = kq * 128; k < kq * 128 + 128; k += 16) {
    float wv[16];
#pragma unroll
    for (int j = 0; j < 16; ++j) wv[j] = w[(size_t)(k + j) * 6144];
#pragma unroll
    for (int j4 = 0; j4 < 4; ++j4)
#pragma unroll
      for (int rr = 0; rr < 17; ++rr) {
        float4 s4 = *(const float4*)(sl + rr * 1024 + k + 4 * j4);
        acc[rr] += s4.x * wv[4 * j4] + s4.y * wv[4 * j4 + 1] + s4.z * wv[4 * j4 + 2] + s4.w * wv[4 * j4 + 3];
      }
  }
  __syncthreads();
  float* red = (float*)(smem + 17 * 1024 * 4);
#pragma unroll
  for (int rr = 0; rr < 17; ++rr) red[(kq * 17 + rr) * 64 + cc] = acc[rr];
  __syncthreads();
  float* mod = (float*)(ws_ + OFF_MOD);
  for (int e = tid; e < 17 * 64; e += NT) {
    int rr = e >> 6, c2 = e & 63;
    float s = 0.f;
#pragma unroll
    for (int q = 0; q < 8; ++q) s += red[(q * 17 + rr) * 64 + c2];
    int n = cb * 64 + c2;
    mod[(size_t)(layer * 17 + rr) * 6144 + n] = s + p.b_mod[layer * 6144 + n];
  }
  __syncthreads();
}

constexpr int T_WIN = 16 * 7, T_WOUT = 64, T_FF = 16 * 11, T_GLU = 4;
constexpr int N_TR_LAYER = T_WIN + T_WOUT + 3 * T_FF + T_GLU;

DI void transpose_item(const Params& p, int idx, char* smem, int wid_s) {
  char* const ws_ = WSL(p);
  const int tid = ((wid_s << 6) | lane_l());
  const int layer = idx / N_TR_LAYER;
  int rem = idx % N_TR_LAYER;
  const float* src; u16* dst; int K, N, mode = 0;
  if (rem < T_WIN) { src = p.w_in + (size_t)layer * DM * INW; K = DM; N = INW; dst = (u16*)(ws_ + OFF_WIN + layer * SZ_WIN); }
  else if ((rem -= T_WIN) < T_WOUT) { src = p.w_out + (size_t)layer * DM * DM; K = DM; N = DM; dst = (u16*)(ws_ + OFF_WOUT + layer * SZ_WOUT); }
  else if ((rem -= T_WOUT) < T_FF) { src = p.w_ff1 + (size_t)layer * DM * DFF; K = DM; N = DFF; dst = (u16*)(ws_ + OFF_W13 + layer * SZ_W13); mode = 1; }
  else if ((rem -= T_FF) < T_FF) { src = p.w_ff3 + (size_t)layer * DM * DFF; K = DM; N = DFF; dst = (u16*)(ws_ + OFF_W13 + layer * SZ_W13); mode = 2; }
  else if ((rem -= T_FF) < T_FF) { src = p.w_ff2 + (size_t)layer * DFF * DM; K = DFF; N = DM; dst = (u16*)(ws_ + OFF_W2 + layer * SZ_W2); }
  else { rem -= T_FF; src = p.w_glu + (size_t)layer * 256 * 256; K = 256; N = 256; dst = (u16*)(ws_ + OFF_WGLU + layer * SZ_WGLU); }
  const int tiles_n = N >> 8;
  const int tk = rem / tiles_n, tn4 = rem % tiles_n;
  float* tile = (float*)smem;
  float4 v[8];
#pragma unroll
  for (int i = 0; i < 8; ++i) {
    const int id = tid + 512 * i;
    const int k = id >> 6, n4 = id & 63;
    v[i] = *(const float4*)(src + (size_t)(tk * 64 + k) * N + tn4 * 256 + 4 * n4);
  }
#pragma unroll
  for (int i = 0; i < 8; ++i) {
    const int id = tid + 512 * i;
    const int k = id >> 6, n4 = id & 63;
    float* tp = tile + (n4 >> 4) * (64 * 65) + k * 65 + 4 * (n4 & 15);
    tp[0] = v[i].x; tp[1] = v[i].y; tp[2] = v[i].z; tp[3] = v[i].w;
  }
  __syncthreads();
  {
    const int n = tid & 63, kc = tid >> 6;
#pragma unroll
    for (int q = 0; q < 4; ++q) {
      const float* tp = tile + q * (64 * 65) + (8 * kc) * 65 + n;
      const int ng = tn4 * 256 + q * 64 + n;
      const int drow = mode == 0 ? ng : ((ng >> 4) * 32 + (ng & 15) + (mode == 2 ? 16 : 0));
      *(uint4*)(dst + (size_t)drow * K + tk * 64 + 8 * kc) =
          make_uint4(pack2(tp[0], tp[65]), pack2(tp[2 * 65], tp[3 * 65]), pack2(tp[4 * 65], tp[5 * 65]), pack2(tp[6 * 65], tp[7 * 65]));
    }
  }
  __syncthreads();
}

DI void wcomb_item(const Params& p, int idx, int wid_s) {
  char* const ws_ = WSL(p);
  const int layer = idx >> 8;
  const int t_ = ((wid_s << 6) | lane_l());
  const int kk = ((idx & 255) << 1) | (t_ >> 8), j = t_ & 255;
  const int half = kk >> 8, hh = (kk >> 6) & 3, c = kk & 63;
  const float* wf = p.w_fourier + (size_t)layer * 256 * 256 + (size_t)(hh * 64) * 256 + j;
  float s = 0.f;
  for (int c2 = 0; c2 < 64; ++c2) {
    float ang = (float)((c * c2) & 63) * (1.f / 32.f);
    float t = half ? -sinpif(ang) : cospif(ang);
    s += t * wf[(size_t)c2 * 256];
  }
  u16* dst = (u16*)(ws_ + OFF_WCOMB + layer * SZ_WCOMB);
  dst[(size_t)j * 512 + kk] = f2bf(s);
}

DI void dft_item(const Params& p, int idx, bool ctxm, int wid_s) {
  char* const ws_ = WSL(p);
  const int e8 = idx * NT + ((wid_s << 6) | lane_l());
  int m, n0, hn, mask; float inv, scale; u16* dst;
  if (!ctxm) { m = e8 >> 8; n0 = (e8 & 255) * 8; hn = 1024; mask = 2047; inv = 1.f / 1024.f; scale = 0.0027621358640099515f; dst = (u16*)(ws_ + OFF_DFTN) + (size_t)m * 2048 + n0; }
  else { m = e8 >> 5; n0 = (e8 & 31) * 8; hn = 128; mask = 255; inv = 1.f / 128.f; scale = 1.f / 128.f; dst = (u16*)(ws_ + OFF_DFTC) + (size_t)m * 256 + n0; }
  const int half = m >= hn ? 1 : 0;
  int np = m - half * hn;
  const bool use_sin = half && np >= 1;
  if (half && np == 0) np = hn;
  unsigned w[4];
#pragma unroll
  for (int j = 0; j < 4; ++j) {
    float a0 = (float)((np * (n0 + 2 * j)) & mask) * inv, a1 = (float)((np * (n0 + 2 * j + 1)) & mask) * inv;
    float v0 = (use_sin ? sinpif(a0) : cospif(a0)) * scale, v1 = (use_sin ? sinpif(a1) : cospif(a1)) * scale;
    w[j] = pack2(v0, v1);
  }
  *(uint4*)dst = make_uint4(w[0], w[1], w[2], w[3]);
}

DI void phase0(const Params& p, char* smem, int wid_s) {
  constexpr int N_MOD = 192, N_TR = 2 * N_TR_LAYER, N_WCOMB = 512, N_DFTN = 1024, N_DFTC = 16;
  constexpr int E1 = N_MOD, E2 = E1 + N_TR, E3 = E2 + N_WCOMB, E4 = E3 + N_DFTN, E5 = E4 + N_DFTC, E6 = E5 + 1;
  for (int it = blockIdx.x; it < E6; it += gridDim.x) {
    if (it < E1) mod_item(p, it, smem, wid_s);
    else if (it < E2) transpose_item(p, it - E1, smem, wid_s);
    else if (it < E3) wcomb_item(p, it - E2, wid_s);
    else if (it < E4) dft_item(p, it - E3, false, wid_s);
    else if (it < E5) dft_item(p, it - E4, true, wid_s);
    else {
      float2* rtab = (float2*)(WSL(p) + OFF_ROPE);
      for (int e = ((wid_s << 6) | lane_l()); e < 1024; e += NT) {
        const int pos = e >> 4, fi = e & 15;
        const float invf = exp2f(-(float)fi * (13.287712379549449f / 16.f)) * 0.3183098861837907f;
        const float a = (float)pos * invf;
        rtab[e] = make_float2(cospif(a), sinpif(a));
      }
    }
  }
}

DI void norm_phase(const float* xlat, const float* xctx, const float* gain, const float* modl, int sh_idx, int sc_idx,
                   u16* dst, int nrows, int wid_s) {
  const int lane = lane_l();
  const int gw = blockIdx.x * NW + wid_s, nw = gridDim.x * NW;
  const int rpw = (nrows + nw - 1) / nw;
  const int r0 = gw * rpw, r1 = min(r0 + rpw, nrows);
  if (r0 >= r1) return;
  float4 gs[4], hs[4], vn[4];
  int cur_mb = -1;
  {
    const float* src = r0 < MLAT ? xlat + (size_t)r0 * 1024 : xctx + (size_t)(r0 - MLAT) * 1024;
#pragma unroll
    for (int i = 0; i < 4; ++i) vn[i] = ((const float4*)src)[lane + 64 * i];
  }
  for (int row = r0; row < r1; ++row) {
    float4 v[4];
#pragma unroll
    for (int i = 0; i < 4; ++i) v[i] = vn[i];
    if (row + 1 < r1) {
      const int rn = row + 1;
      const float* src = rn < MLAT ? xlat + (size_t)rn * 1024 : xctx + (size_t)(rn - MLAT) * 1024;
#pragma unroll
      for (int i = 0; i < 4; ++i) vn[i] = ((const float4*)src)[lane + 64 * i];
    }
    const int mb = row < MLAT ? (row >> 11) : 16;
    if (mb != cur_mb) {
      cur_mb = mb;
      const float* sh = modl + (size_t)mb * 6144 + sh_idx * 1024;
      const float* sc = modl + (size_t)mb * 6144 + sc_idx * 1024;
#pragma unroll
      for (int i = 0; i < 4; ++i) {
        const int c4 = lane + 64 * i;
        float4 g4 = ((const float4*)gain)[c4], s4 = ((const float4*)sc)[c4];
        hs[i] = ((const float4*)sh)[c4];
        gs[i] = make_float4(g4.x * (1.f + s4.x), g4.y * (1.f + s4.y), g4.z * (1.f + s4.z), g4.w * (1.f + s4.w));
      }
    }
    float ss = 0.f;
#pragma unroll
    for (int i = 0; i < 4; ++i) ss += v[i].x * v[i].x + v[i].y * v[i].y + v[i].z * v[i].z + v[i].w * v[i].w;
#pragma unroll
    for (int o = 32; o >= 1; o >>= 1) ss += shx(ss, o, lane);
    const float rstd = rsqrtf(ss * (1.f / 1024.f) + 1e-6f);
#pragma unroll
    for (int i = 0; i < 4; ++i) {
      const int c4 = lane + 64 * i;
      float y0 = v[i].x * rstd * gs[i].x + hs[i].x;
      float y1 = v[i].y * rstd * gs[i].y + hs[i].y;
      float y2 = v[i].z * rstd * gs[i].z + hs[i].z;
      float y3 = v[i].w * rstd * gs[i].w + hs[i].w;
      *(uint2*)(dst + (size_t)row * 1024 + c4 * 4) = make_uint2(pack2(y0, y1), pack2(y2, y3));
    }
  }
}

DI void groupnorm_phase(const u16* oraw, const float* gg, u16* dst, int nrows, int wid_s) {
  const int lane = lane_l();
  const int gw = blockIdx.x * NW + wid_s, nw = gridDim.x * NW;
  const int rpw = (nrows + nw - 1) / nw;
  const int r0 = gw * rpw, r1 = min(r0 + rpw, nrows);
  if (r0 >= r1) return;
  float g[16];
#pragma unroll
  for (int j = 0; j < 4; ++j) {
    float4 t = ((const float4*)(gg + lane * 16))[j];
    g[4 * j] = t.x; g[4 * j + 1] = t.y; g[4 * j + 2] = t.z; g[4 * j + 3] = t.w;
  }
  bf16x8 an, bn;
  {
    const u16* src = oraw + (size_t)r0 * 1024 + lane * 16;
    an = *(const bf16x8*)src; bn = *(const bf16x8*)(src + 8);
  }
  for (int row = r0; row < r1; ++row) {
    bf16x8 a = an, b = bn;
    if (row + 1 < r1) {
      const u16* src = oraw + (size_t)(row + 1) * 1024 + lane * 16;
      an = *(const bf16x8*)src; bn = *(const bf16x8*)(src + 8);
    }
    float v[16];
    float ss = 0.f;
#pragma unroll
    for (int j = 0; j < 8; ++j) { v[j] = bf2f((u16)a[j]); v[8 + j] = bf2f((u16)b[j]); }
#pragma unroll
    for (int j = 0; j < 16; ++j) ss += v[j] * v[j];
#pragma unroll
    for (int o = 8; o >= 1; o >>= 1) ss += shx(ss, o, lane);
    const float rstd = rsqrtf(ss * (1.f / 256.f) + 1e-6f);
    unsigned w[8];
#pragma unroll
    for (int j = 0; j < 8; ++j) w[j] = pack2(v[2 * j] * rstd * g[2 * j], v[2 * j + 1] * rstd * g[2 * j + 1]);
    uint4* d4 = (uint4*)(dst + (size_t)row * 1024 + lane * 16);
    d4[0] = make_uint4(w[0], w[1], w[2], w[3]);
    d4[1] = make_uint4(w[4], w[5], w[6], w[7]);
  }
}

DI void prep_setup(const Params& p, int L, char* smem, int wid_s) {
  char* const ws_ = WSL(p);
  const int tid = ((wid_s << 6) | lane_l());
  float* gl = (float*)(smem + 49152);
  if (tid < 256) {
    const int kind = tid >> 6, e = tid & 63;
    const float* gn = (kind == 0 ? p.att_q_gain : kind == 1 ? p.att_k_gain : kind == 2 ? p.na_q_gain : p.na_k_gain) + L * 64;
    gl[tid] = gn[e];
  }
  const float2* rg = (const float2*)(ws_ + OFF_ROPE);
  float2* rl = (float2*)(smem + 53248);
  for (int i = tid; i < 1024; i += NT) { const int pos = i >> 4, e = i & 15; rl[e * 64 + pos] = rg[i]; }
  __syncthreads();
}

DI void prep_item(const Params& p, int L, int item, char* smem, int wid_s) {
  char* const ws_ = WSL(p);
  const int tid = ((wid_s << 6) | lane_l());
  const int b = item / 72, t = item % 72;
  const int row0 = t < 64 ? b * 2048 + 32 * t : MLAT + b * 256 + 32 * (t - 64);
  const u16* proj = (const u16*)(ws_ + OFF_PROJ);
  u16* tl = (u16*)smem;
  for (int id = tid; id < 2560; id += NT) {
    int row = id / 80, cc = id % 80;
    int scol = cc < 16 ? 384 + 8 * cc : (cc < 48 ? 1024 + 8 * (cc - 16) : 1280 + 8 * (cc - 48));
    uint4 v = *(const uint4*)(proj + (size_t)(row0 + row) * INW + scol);
    unsigned* d = (unsigned*)(tl + row * 642 + 8 * cc);
    d[0] = v.x; d[1] = v.y; d[2] = v.z; d[3] = v.w;
  }
  for (int pi = tid; pi < 448; pi += NT) {
    const int i = pi & 31, hv = pi >> 5;
    int col, kind, hd;
    if (hv < 4) { kind = 0; hd = hv; col = 64 * hd; }
    else if (hv < 6) { kind = 1; hd = hv - 4; col = 256 + 64 * hd; }
    else if (hv < 10) { kind = 2; hd = hv - 6; col = 512 + 64 * hd; }
    else { kind = 3; hd = hv - 10; col = 768 + 64 * hd; }
    const u16* src = proj + (size_t)(row0 + i) * INW + col;
    float v[64];
    float ss = 0.f;
#pragma unroll
    for (int q = 0; q < 8; ++q) {
      bf16x8 a = *(const bf16x8*)(src + 8 * q);
#pragma unroll
      for (int j = 0; j < 8; ++j) { v[8 * q + j] = bf2f((u16)a[j]); ss += v[8 * q + j] * v[8 * q + j]; }
    }
    const float rstd = rsqrtf(ss * (1.f / 64.f) + 1e-6f);
    const float4* gn4 = (const float4*)(smem + 49152) + kind * 16;
#pragma unroll
    for (int e4 = 0; e4 < 16; ++e4) {
      const float4 g4 = gn4[e4];
      v[4 * e4] *= rstd * g4.x; v[4 * e4 + 1] *= rstd * g4.y; v[4 * e4 + 2] *= rstd * g4.z; v[4 * e4 + 3] *= rstd * g4.w;
    }
    if (kind < 2 && t < 64) {
      const int n = 32 * t + i;
      const float2* rtab = (const float2*)(smem + 53248);
#pragma unroll
      for (int e = 0; e < 16; ++e) {
        const float2 tr = rtab[e * 64 + (n >> 6)], tc = rtab[e * 64 + (n & 63)];
        const float cr = tr.x, sr = tr.y, c2 = tc.x, s2 = tc.y;
        float t1 = v[e], t2 = v[16 + e];
        v[e] = t1 * cr - t2 * sr; v[16 + e] = t2 * cr + t1 * sr;
        t1 = v[32 + e]; t2 = v[48 + e];
        v[32 + e] = t1 * c2 - t2 * s2; v[48 + e] = t2 * c2 + t1 * s2;
      }
    }
    const int seqpos = 32 * t + i;
    u16* dst;
    if (kind == 0) dst = (u16*)(ws_ + OFF_AQ) + ((size_t)(b * 4 + hd) * SL + seqpos) * 64;
    else if (kind == 1) dst = (u16*)(ws_ + OFF_AK) + ((size_t)(b * 2 + hd) * SL + seqpos) * 64;
    else if (kind == 2) dst = (u16*)(ws_ + OFF_DQ) + ((size_t)(b * 4 + hd) * SL + seqpos) * 64;
    else dst = (u16*)(ws_ + OFF_DK) + ((size_t)(b * 4 + hd) * SL + seqpos) * 64;
    const int ksw = (kind & 1) ? ((seqpos >> 1) & 7) : 0;
#pragma unroll
    for (int q = 0; q < 8; ++q) {
      uint4 o4 = make_uint4(pack2(v[8 * q], v[8 * q + 1]), pack2(v[8 * q + 2], v[8 * q + 3]), pack2(v[8 * q + 4], v[8 * q + 5]), pack2(v[8 * q + 6], v[8 * q + 7]));
      *(uint4*)(dst + 8 * (q ^ ksw)) = o4;
    }
  }
  __syncthreads();
  for (int id = tid; id < 1536; id += NT) {
    int kg = id & 3, d = (id >> 2) & 63, hd6 = id >> 8;
    const u16* s = tl + (8 * kg) * 642 + hd6 * 64 + d;
    uint2 lo = make_uint2((unsigned)s[0] | ((unsigned)s[642] << 16), (unsigned)s[2 * 642] | ((unsigned)s[3 * 642] << 16));
    uint2 hi = make_uint2((unsigned)s[4 * 642] | ((unsigned)s[5 * 642] << 16), (unsigned)s[6 * 642] | ((unsigned)s[7 * 642] << 16));
    u16* dst = hd6 < 2 ? (u16*)(ws_ + OFF_AVT) + ((size_t)(b * 2 + hd6) * 72 + t) * 2048 + d * 32
                       : (u16*)(ws_ + OFF_DVT) + ((size_t)(b * 4 + hd6 - 2) * 72 + t) * 2048 + d * 32;
    const int vsw = (d >> 2) & 7;
    *(uint2*)(dst + 4 * ((2 * kg) ^ vsw)) = lo;
    *(uint2*)(dst + 4 * ((2 * kg + 1) ^ vsw)) = hi;
  }
  for (int id = tid; id < 1024; id += NT) {
    int kg = id & 3, ch = id >> 2;
    const u16* s = tl + (8 * kg) * 642 + 384 + ch;
    uint4 o4 = make_uint4((unsigned)s[0] | ((unsigned)s[642] << 16), (unsigned)s[2 * 642] | ((unsigned)s[3 * 642] << 16),
                          (unsigned)s[4 * 642] | ((unsigned)s[5 * 642] << 16), (unsigned)s[6 * 642] | ((unsigned)s[7 * 642] << 16));
    u16* dst = t < 64 ? (u16*)(ws_ + OFF_FINT) + ((size_t)(b * 256 + ch)) * 2048 + 32 * t + 8 * kg
                      : (u16*)(ws_ + OFF_FINTC) + ((size_t)(b * 256 + ch)) * 256 + 32 * (t - 64) + 8 * kg;
    *(uint4*)dst = o4;
  }
  __syncthreads();
}

template <bool NA>
DI void attn_wave(const u16* __restrict__ Q, const u16* __restrict__ Kb, const u16* __restrict__ Vt, int ta0, int ta1,
                  int tb0, int tb1, u16* __restrict__ O, const float* __restrict__ bias, int qrow, int qcol, int wid_s) {
  const int lane = ((wid_s << 6) | lane_l()) & 63, r = lane & 31, h = lane >> 5;
  bf16x8 qf[4];
#pragma unroll
  for (int s = 0; s < 4; ++s) qf[s] = *(const bf16x8*)(Q + r * 64 + 16 * s + 8 * h);
  f32x16 o0, o1;
#pragma unroll
  for (int e = 0; e < 16; ++e) { o0[e] = 0.f; o1[e] = 0.f; }
  float m_run = -1e30f, l_run = 0.f;
  const int qc = qcol + r;
  const int cs = min(max(qc - 8, 0), 48);
  for (int pass = 0; pass < 2; ++pass) {
    const int t0 = pass == 0 ? tb0 : ta0, t1 = pass == 0 ? tb1 : ta1;
    const bool masked = NA && pass == 1;
    for (int t = t0; t < t1; ++t) {
      const u16* kp = Kb + (size_t)(32 * t + r) * 64 + 8 * h;
      bf16x8 k0 = *(const bf16x8*)(kp), k1 = *(const bf16x8*)(kp + 16), k2 = *(const bf16x8*)(kp + 32), k3 = *(const bf16x8*)(kp + 48);
      const u16* vp = Vt + (size_t)t * 2048 + r * 32 + 4 * h;
      bf16x4 va0 = *(const bf16x4*)(vp), va1 = *(const bf16x4*)(vp + 8), va2 = *(const bf16x4*)(vp + 16), va3 = *(const bf16x4*)(vp + 24);
      bf16x4 vb0 = *(const bf16x4*)(vp + 1024), vb1 = *(const bf16x4*)(vp + 1032), vb2 = *(const bf16x4*)(vp + 1040), vb3 = *(const bf16x4*)(vp + 1048);
      f32x16 s;
#pragma unroll
      for (int e = 0; e < 16; ++e) s[e] = 0.f;
      s = MFMA32(k0, qf[0], s);
      s = MFMA32(k1, qf[1], s);
      s = MFMA32(k2, qf[2], s);
      s = MFMA32(k3, qf[3], s);
      float mx = -1e30f;
      bool valid[16];
#pragma unroll
      for (int e = 0; e < 16; ++e) {
        float sc = s[e] * 0.125f;
        valid[e] = true;
        if (masked) {
          const int key = (e & 3) + 8 * (e >> 2) + 4 * h;
          const int kc = (t & 1) * 32 + key, kr = t >> 1;
          valid[e] = (kc >= cs) && (kc < cs + 16);
          const int dc = min(max(kc - qc + 15, 0), 30);
          const int dr = min(max(kr - qrow + 7, 0), 14);
          sc = valid[e] ? sc + bias[dr * 31 + dc] : -1e30f;
        }
        s[e] = sc;
        mx = fmaxf(mx, sc);
      }
      mx = fmaxf(mx, shx(mx, 32, lane));
      const float m_new = fmaxf(m_run, mx);
      const float alpha = __expf(m_run - m_new);
      float ps = 0.f;
#pragma unroll
      for (int e = 0; e < 16; ++e) {
        float pe = __expf(s[e] - m_new);
        if (masked) pe = valid[e] ? pe : 0.f;
        s[e] = pe;
        ps += pe;
      }
      l_run = l_run * alpha + ps;
      m_run = m_new;
#pragma unroll
      for (int e = 0; e < 16; ++e) { o0[e] *= alpha; o1[e] *= alpha; }
      typedef unsigned u32x4_t __attribute__((ext_vector_type(4)));
      u32x4_t pw0 = {pack2(s[0], s[1]), pack2(s[2], s[3]), pack2(s[4], s[5]), pack2(s[6], s[7])};
      u32x4_t pw1 = {pack2(s[8], s[9]), pack2(s[10], s[11]), pack2(s[12], s[13]), pack2(s[14], s[15])};
      bf16x8 pf0 = __builtin_bit_cast(bf16x8, pw0), pf1 = __builtin_bit_cast(bf16x8, pw1);
      bf16x8 v00 = __builtin_shufflevector(va0, va1, 0, 1, 2, 3, 4, 5, 6, 7);
      bf16x8 v01 = __builtin_shufflevector(va2, va3, 0, 1, 2, 3, 4, 5, 6, 7);
      bf16x8 v10 = __builtin_shufflevector(vb0, vb1, 0, 1, 2, 3, 4, 5, 6, 7);
      bf16x8 v11 = __builtin_shufflevector(vb2, vb3, 0, 1, 2, 3, 4, 5, 6, 7);
      o0 = MFMA32(v00, pf0, o0);
      o0 = MFMA32(v01, pf1, o0);
      o1 = MFMA32(v10, pf0, o1);
      o1 = MFMA32(v11, pf1, o1);
    }
  }
  float l = l_run + shx(l_run, 32, lane);
  const float inv = 1.f / l;
#pragma unroll
  for (int g4 = 0; g4 < 4; ++g4) {
    uint2 w0 = make_uint2(pack2(o0[4 * g4] * inv, o0[4 * g4 + 1] * inv), pack2(o0[4 * g4 + 2] * inv, o0[4 * g4 + 3] * inv));
    uint2 w1 = make_uint2(pack2(o1[4 * g4] * inv, o1[4 * g4 + 1] * inv), pack2(o1[4 * g4 + 2] * inv, o1[4 * g4 + 3] * inv));
    *(uint2*)(O + (size_t)r * 1024 + 8 * g4 + 4 * h) = w0;
    *(uint2*)(O + (size_t)r * 1024 + 32 + 8 * g4 + 4 * h) = w1;
  }
}

template <bool NA>
DI void attn_block(const u16* __restrict__ Q, const char* __restrict__ Kg, const char* __restrict__ Vg, int sa0, int sa1,
                   int sb0, int sb1, u16* __restrict__ O, const float* __restrict__ bias, int qrow, int qcol, int rs,
                   char* smem, int wid_s) {
  const int lane = lane_l(), tid = (wid_s << 6) | lane, r = lane & 31, h = lane >> 5;
  bf16x8 qf[4];
#pragma unroll
  for (int s = 0; s < 4; ++s) qf[s] = *(const bf16x8*)(Q + r * 64 + 16 * s + 8 * h);
  f32x16 o0, o1;
#pragma unroll
  for (int e = 0; e < 16; ++e) { o0[e] = 0.f; o1[e] = 0.f; }
  float m_run = -1e30f, l_run = 0.f;
  const int qc = qcol + r;
  const int cs = min(max(qc - 8, 0), 48);
  const int nb = sb1 - sb0, ntot = nb + (sa1 - sa0);
  const float SC = 0.125f * 1.4426950408889634f, L2E = 1.4426950408889634f;
  float* btab = (float*)(smem + 41216);
  unsigned vmask = 0xffffffffu;
  if (NA) {
    for (int i2 = tid; i2 < 465; i2 += NT) btab[i2] = bias[i2] * L2E;
    vmask = 0u;
#pragma unroll
    for (int u = 0; u < 2; ++u)
#pragma unroll
      for (int e = 0; e < 16; ++e) {
        const int kc = u * 32 + (e & 3) + 8 * (e >> 2) + 4 * h;
        if (kc >= cs && kc < cs + 16) vmask |= 1u << (16 * u + e);
      }
  }
  const int lb = 15 - qc + 4 * h;
  uint4 kreg, vreg;
  {
    const int st0 = nb > 0 ? sb0 : sa0;
    kreg = *(const uint4*)(Kg + (size_t)st0 * 8192 + tid * 16);
    vreg = *(const uint4*)(Vg + (size_t)st0 * 8192 + tid * 16);
    *(uint4*)(smem + tid * 16) = kreg;
    *(uint4*)(smem + 8192 + tid * 16) = vreg;
  }
  __syncthreads();
  uint4 k2 = kreg, v2 = vreg;
  if (ntot > 1) {
    const int s1 = 1 < nb ? sb0 + 1 : sa0 + (1 - nb);
    kreg = *(const uint4*)(Kg + (size_t)s1 * 8192 + tid * 16);
    vreg = *(const uint4*)(Vg + (size_t)s1 * 8192 + tid * 16);
  }
  for (int i = 0; i < ntot; ++i) {
    const int st = i < nb ? sb0 + i : sa0 + (i - nb);
    if (i + 2 < ntot) {
      const int sn = (i + 2) < nb ? sb0 + i + 2 : sa0 + (i + 2 - nb);
      k2 = *(const uint4*)(Kg + (size_t)sn * 8192 + tid * 16);
      v2 = *(const uint4*)(Vg + (size_t)sn * 8192 + tid * 16);
    }
    const char* kb = smem + (i & 1) * 16384;
    const char* vb = kb + 8192;
    const bool masked = NA && i >= nb;
    const bool active = !masked || (st >= rs && st < rs + 8);
    if (active) {
      f32x16 sv[2];
      bf16x4 va[2][4], vb4[2][4];
#pragma unroll
      for (int u = 0; u < 2; ++u) {
        const int R = 32 * u + r;
        const char* kp = kb + R * 128;
        const int ksw = (R >> 1) & 7;
        bf16x8 k0 = *(const bf16x8*)(kp + (((0 + h) ^ ksw) << 4)), k1 = *(const bf16x8*)(kp + (((2 + h) ^ ksw) << 4));
        bf16x8 k2 = *(const bf16x8*)(kp + (((4 + h) ^ ksw) << 4)), k3 = *(const bf16x8*)(kp + (((6 + h) ^ ksw) << 4));
        f32x16 s;
#pragma unroll
        for (int e = 0; e < 16; ++e) s[e] = 0.f;
        __builtin_amdgcn_s_setprio(1);
        s = MFMA32(k0, qf[0], s);
        s = MFMA32(k1, qf[1], s);
        s = MFMA32(k2, qf[2], s);
        s = MFMA32(k3, qf[3], s);
        __builtin_amdgcn_s_setprio(0);
        sv[u] = s;
        const int vsw = (r >> 2) & 7;
        const char* vp = vb + u * 4096 + r * 64;
#pragma unroll
        for (int q = 0; q < 4; ++q) {
          va[u][q] = *(const bf16x4*)(vp + (((2 * q + h) ^ vsw) << 3));
          vb4[u][q] = *(const bf16x4*)(vp + 2048 + (((2 * q + h) ^ vsw) << 3));
        }
      }
      float mx = -1e30f;
      if (masked) {
#pragma unroll
        for (int u = 0; u < 2; ++u)
#pragma unroll
          for (int e = 0; e < 16; ++e) {
            const bool vld = (vmask >> (16 * u + e)) & 1u;
            const float* bp = btab + (st - qrow + 7) * 31 + lb;
            const float sc = vld ? sv[u][e] * SC + bp[32 * u + (e & 3) + 8 * (e >> 2)] : -1e30f;
            sv[u][e] = sc;
            mx = fmaxf(mx, sc);
          }
      } else {
#pragma unroll
        for (int u = 0; u < 2; ++u)
#pragma unroll
          for (int e = 0; e < 16; e += 2) mx = fmaxf(mx, fmaxf(sv[u][e], sv[u][e + 1]));
        mx *= SC;
      }
      mx = fmaxf(mx, shx(mx, 32, lane));
      const float m_new = fmaxf(m_run, mx);
      if (__any(m_new > m_run)) {
        const float alpha = __builtin_amdgcn_exp2f(m_run - m_new);
        l_run *= alpha;
        const f32x2_t al2 = {alpha, alpha};
#pragma unroll
        for (int e = 0; e < 16; e += 2) {
          f32x2_t a0 = {o0[e], o0[e + 1]}, a1 = {o1[e], o1[e + 1]};
          a0 *= al2; a1 *= al2;
          o0[e] = a0[0]; o0[e + 1] = a0[1]; o1[e] = a1[0]; o1[e + 1] = a1[1];
        }
        m_run = m_new;
      }
      f32x2_t ps2 = {0.f, 0.f};
      if (masked) {
#pragma unroll
        for (int u = 0; u < 2; ++u)
#pragma unroll
          for (int e = 0; e < 16; ++e) {
            float pe = __builtin_amdgcn_exp2f(sv[u][e] - m_run);
            pe = ((vmask >> (16 * u + e)) & 1u) ? pe : 0.f;
            sv[u][e] = pe;
            ps2[e & 1] += pe;
          }
      } else {
        const f32x2_t sc2 = {SC, SC}, nm2 = {-m_run, -m_run};
#pragma unroll
        for (int u = 0; u < 2; ++u)
#pragma unroll
          for (int e = 0; e < 16; e += 2) {
            f32x2_t x = {sv[u][e], sv[u][e + 1]};
            x = x * sc2 + nm2;
            f32x2_t pe = {__builtin_amdgcn_exp2f(x[0]), __builtin_amdgcn_exp2f(x[1])};
            sv[u][e] = pe[0]; sv[u][e + 1] = pe[1];
            ps2 += pe;
          }
      }
      l_run += ps2[0] + ps2[1];
      typedef unsigned u32x4_t __attribute__((ext_vector_type(4)));
#pragma unroll
      for (int u = 0; u < 2; ++u) {
        u32x4_t pw0 = {pack2(sv[u][0], sv[u][1]), pack2(sv[u][2], sv[u][3]), pack2(sv[u][4], sv[u][5]), pack2(sv[u][6], sv[u][7])};
        u32x4_t pw1 = {pack2(sv[u][8], sv[u][9]), pack2(sv[u][10], sv[u][11]), pack2(sv[u][12], sv[u][13]), pack2(sv[u][14], sv[u][15])};
        bf16x8 pf0 = __builtin_bit_cast(bf16x8, pw0), pf1 = __builtin_bit_cast(bf16x8, pw1);
        bf16x8 v00 = __builtin_shufflevector(va[u][0], va[u][1], 0, 1, 2, 3, 4, 5, 6, 7);
        bf16x8 v01 = __builtin_shufflevector(va[u][2], va[u][3], 0, 1, 2, 3, 4, 5, 6, 7);
        bf16x8 v10 = __builtin_shufflevector(vb4[u][0], vb4[u][1], 0, 1, 2, 3, 4, 5, 6, 7);
        bf16x8 v11 = __builtin_shufflevector(vb4[u][2], vb4[u][3], 0, 1, 2, 3, 4, 5, 6, 7);
        __builtin_amdgcn_s_setprio(1);
        o0 = MFMA32(v00, pf0, o0);
        o0 = MFMA32(v01, pf1, o0);
        o1 = MFMA32(v10, pf0, o1);
        o1 = MFMA32(v11, pf1, o1);
        __builtin_amdgcn_s_setprio(0);
      }
    }
    if (i + 1 < ntot) {
      char* nbuf = smem + ((i + 1) & 1) * 16384;
      *(uint4*)(nbuf + tid * 16) = kreg;
      *(uint4*)(nbuf + 8192 + tid * 16) = vreg;
    }
    lds_barrier();
    kreg = k2; vreg = v2;
  }
  __syncthreads();
  float l = l_run + shx(l_run, 32, lane);
  const float inv = 1.f / l;
#pragma unroll
  for (int g4 = 0; g4 < 4; ++g4) {
    uint2 w0 = make_uint2(pack2(o0[4 * g4] * inv, o0[4 * g4 + 1] * inv), pack2(o0[4 * g4 + 2] * inv, o0[4 * g4 + 3] * inv));
    uint2 w1 = make_uint2(pack2(o1[4 * g4] * inv, o1[4 * g4 + 1] * inv), pack2(o1[4 * g4 + 2] * inv, o1[4 * g4 + 3] * inv));
    *(uint2*)(O + (size_t)r * 1024 + 8 * g4 + 4 * h) = w0;
    *(uint2*)(O + (size_t)r * 1024 + 32 + 8 * g4 + 4 * h) = w1;
  }
}

DI void na_block(const u16* __restrict__ Qh, const char* __restrict__ Kg, const char* __restrict__ Vg, int sa0, int sa1,
                 int sb0, int sb1, u16* __restrict__ Oh, const float* __restrict__ bias, int r0, int c0, char* smem, int wid_s) {
  const int lane = lane_l(), tid = (wid_s << 6) | lane, r = lane & 31, h = lane >> 5;
  const int qrow = r0 + (r >> 4), qc = c0 + (r & 15);
  const int token = qrow * 64 + qc;
  bf16x8 qf[4];
#pragma unroll
  for (int s = 0; s < 4; ++s) qf[s] = *(const bf16x8*)(Qh + (size_t)token * 64 + 16 * s + 8 * h);
  f32x16 o0, o1;
#pragma unroll
  for (int e = 0; e < 16; ++e) { o0[e] = 0.f; o1[e] = 0.f; }
  float m_run = -1e30f, l_run = 0.f;
  const int cs = min(max(qc - 8, 0), 48);
  const int rs_l = min(max(qrow - 4, 0), 24);
  const int k0 = min(max(c0 - 8, 0), 32);
  const int wrs0 = min(max(r0 - 4, 0), 24), wrs1 = min(max(r0 - 3, 0), 24);
  const int nb = sb1 - sb0, ntot = nb + (sa1 - sa0);
  const float SC = 0.125f * 1.4426950408889634f, L2E = 1.4426950408889634f;
  float* btab = (float*)(smem + 41216);
  for (int i2 = tid; i2 < 465; i2 += NT) btab[i2] = bias[i2] * L2E;
  unsigned vmask = 0u;
#pragma unroll
  for (int e = 0; e < 16; ++e) {
    const int kc = k0 + (e & 3) + 8 * (e >> 2) + 4 * h;
    if (kc >= cs && kc < cs + 16) vmask |= 1u << e;
  }
  const int lb = 15 - qc + 4 * h + k0;
  uint4 kreg, vreg;
  {
    const int st0 = nb > 0 ? sb0 : sa0;
    kreg = *(const uint4*)(Kg + (size_t)st0 * 8192 + tid * 16);
    vreg = *(const uint4*)(Vg + (size_t)st0 * 8192 + tid * 16);
    *(uint4*)(smem + tid * 16) = kreg;
    *(uint4*)(smem + 8192 + tid * 16) = vreg;
  }
  __syncthreads();
  uint4 k2 = kreg, v2 = vreg;
  if (ntot > 1) {
    const int s1 = 1 < nb ? sb0 + 1 : sa0 + (1 - nb);
    kreg = *(const uint4*)(Kg + (size_t)s1 * 8192 + tid * 16);
    vreg = *(const uint4*)(Vg + (size_t)s1 * 8192 + tid * 16);
  }
  for (int i = 0; i < ntot; ++i) {
    const int st = i < nb ? sb0 + i : sa0 + (i - nb);
    if (i + 2 < ntot) {
      const int sn = (i + 2) < nb ? sb0 + i + 2 : sa0 + (i + 2 - nb);
      k2 = *(const uint4*)(Kg + (size_t)sn * 8192 + tid * 16);
      v2 = *(const uint4*)(Vg + (size_t)sn * 8192 + tid * 16);
    }
    const char* kb = smem + (i & 1) * 16384;
    const char* vb = kb + 8192;
    const bool masked = i >= nb;
    const bool active = !masked || (st >= wrs0 && st < wrs1 + 8);
    if (active) {
      const int nsub = masked ? 1 : 2;
      const bool rowok = st >= rs_l && st < rs_l + 8;
      for (int u = 0; u < nsub; ++u) {
        const int koff = masked ? k0 : 32 * u;
        const int R = koff + r;
        const char* kp = kb + R * 128;
        const int ksw = (R >> 1) & 7;
        bf16x8 k0f = *(const bf16x8*)(kp + (((0 + h) ^ ksw) << 4)), k1f = *(const bf16x8*)(kp + (((2 + h) ^ ksw) << 4));
        bf16x8 k2f = *(const bf16x8*)(kp + (((4 + h) ^ ksw) << 4)), k3f = *(const bf16x8*)(kp + (((6 + h) ^ ksw) << 4));
        const int vsw = (r >> 2) & 7;
        const int g0 = (koff >> 2) + h;
        bf16x4 va[4], vb4[4];
#pragma unroll
        for (int q = 0; q < 4; ++q) {
          const int g = g0 + 2 * q;
          const char* vp = vb + (g >> 3) * 4096 + r * 64 + (((g & 7) ^ vsw) << 3);
          va[q] = *(const bf16x4*)vp;
          vb4[q] = *(const bf16x4*)(vp + 2048);
        }
        f32x16 s;
#pragma unroll
        for (int e = 0; e < 16; ++e) s[e] = 0.f;
        __builtin_amdgcn_s_setprio(1);
        s = MFMA32(k0f, qf[0], s);
        s = MFMA32(k1f, qf[1], s);
        s = MFMA32(k2f, qf[2], s);
        s = MFMA32(k3f, qf[3], s);
        __builtin_amdgcn_s_setprio(0);
        float mx = -1e30f;
        if (masked) {
          const float* bp = btab + (st - qrow + 7) * 31 + lb;
#pragma unroll
          for (int e = 0; e < 16; ++e) {
            const bool vld = rowok && ((vmask >> e) & 1u);
            const float sc = vld ? s[e] * SC + bp[(e & 3) + 8 * (e >> 2)] : -1e30f;
            s[e] = sc;
            mx = fmaxf(mx, sc);
          }
        } else {
#pragma unroll
          for (int e = 0; e < 16; ++e) { s[e] *= SC; mx = fmaxf(mx, s[e]); }
        }
        mx = fmaxf(mx, shx(mx, 32, lane));
        const float m_new = fmaxf(m_run, mx);
        if (__any(m_new > m_run)) {
          const float alpha = __builtin_amdgcn_exp2f(m_run - m_new);
          l_run *= alpha;
#pragma unroll
          for (int e = 0; e < 16; ++e) { o0[e] *= alpha; o1[e] *= alpha; }
          m_run = m_new;
        }
        float ps = 0.f;
#pragma unroll
        for (int e = 0; e < 16; ++e) {
          float pe = __builtin_amdgcn_exp2f(s[e] - m_run);
          if (masked) pe = (rowok && ((vmask >> e) & 1u)) ? pe : 0.f;
          s[e] = pe;
          ps += pe;
        }
        l_run += ps;
        typedef unsigned u32x4_t __attribute__((ext_vector_type(4)));
        u32x4_t pw0 = {pack2(s[0], s[1]), pack2(s[2], s[3]), pack2(s[4], s[5]), pack2(s[6], s[7])};
        u32x4_t pw1 = {pack2(s[8], s[9]), pack2(s[10], s[11]), pack2(s[12], s[13]), pack2(s[14], s[15])};
        bf16x8 pf0 = __builtin_bit_cast(bf16x8, pw0), pf1 = __builtin_bit_cast(bf16x8, pw1);
        bf16x8 v00 = __builtin_shufflevector(va[0], va[1], 0, 1, 2, 3, 4, 5, 6, 7);
        bf16x8 v01 = __builtin_shufflevector(va[2], va[3], 0, 1, 2, 3, 4, 5, 6, 7);
        bf16x8 v10 = __builtin_shufflevector(vb4[0], vb4[1], 0, 1, 2, 3, 4, 5, 6, 7);
        bf16x8 v11 = __builtin_shufflevector(vb4[2], vb4[3], 0, 1, 2, 3, 4, 5, 6, 7);
        __builtin_amdgcn_s_setprio(1);
        o0 = MFMA32(v00, pf0, o0);
        o0 = MFMA32(v01, pf1, o0);
        o1 = MFMA32(v10, pf0, o1);
        o1 = MFMA32(v11, pf1, o1);
        __builtin_amdgcn_s_setprio(0);
      }
    }
    if (i + 1 < ntot) {
      char* nbuf = smem + ((i + 1) & 1) * 16384;
      *(uint4*)(nbuf + tid * 16) = kreg;
      *(uint4*)(nbuf + 8192 + tid * 16) = vreg;
    }
    lds_barrier();
    kreg = k2; vreg = v2;
  }
  __syncthreads();
  float l = l_run + shx(l_run, 32, lane);
  const float inv = 1.f / l;
  u16* O = Oh + (size_t)token * 1024;
#pragma unroll
  for (int g4 = 0; g4 < 4; ++g4) {
    uint2 w0 = make_uint2(pack2(o0[4 * g4] * inv, o0[4 * g4 + 1] * inv), pack2(o0[4 * g4 + 2] * inv, o0[4 * g4 + 3] * inv));
    uint2 w1 = make_uint2(pack2(o1[4 * g4] * inv, o1[4 * g4 + 1] * inv), pack2(o1[4 * g4 + 2] * inv, o1[4 * g4 + 3] * inv));
    *(uint2*)(O + 8 * g4 + 4 * h) = w0;
    *(uint2*)(O + 32 + 8 * g4 + 4 * h) = w1;
  }
}

DI void s5_wave(const Params& p, int L, int witem, bool need_ctx, char* sw, u16* ysb, int wid_s) {
  char* const ws_ = WSL(p);
  const int lane = ((wid_s << 6) | lane_l()) & 63;
  const int b = witem >> 5, g = (witem >> 1) & 15, dir = witem & 1;
  float* BU = (float*)sw;
  unsigned* HS = (unsigned*)(sw + 16 * 132 * 4);
  u16* ysd = ysb + (size_t)dir * MT * 256;
  const int pg = (L * 2 + dir) * 16 + g;
  const float dt = __expf(p.log_dt[pg]);
  float a_re, a_im;
  {
    const float lr = p.lam_re[pg * 64 + lane], li = p.lam_im[pg * 64 + lane];
    const float mag = __expf(lr * dt);
    const float ang = li * dt * 0.3183098861837907f;
    a_re = mag * cospif(ang); a_im = mag * sinpif(ang);
    const float den = 1.f / (lr * lr + li * li);
    const float f_re = ((a_re - 1.f) * lr + a_im * li) * den;
    const float f_im = (a_im * lr - (a_re - 1.f) * li) * den;
    const float* br = p.b_re + ((size_t)pg * 64 + lane) * 16;
    const float* bi = p.b_im + ((size_t)pg * 64 + lane) * 16;
#pragma unroll
    for (int c4 = 0; c4 < 4; ++c4) {
      float4 r4 = *(const float4*)(br + 4 * c4), i4 = *(const float4*)(bi + 4 * c4);
      float4 ore = make_float4(f_re * r4.x - f_im * i4.x, f_re * r4.y - f_im * i4.y, f_re * r4.z - f_im * i4.z, f_re * r4.w - f_im * i4.w);
      float4 oim = make_float4(f_re * i4.x + f_im * r4.x, f_re * i4.y + f_im * r4.y, f_re * i4.z + f_im * r4.z, f_re * i4.w + f_im * r4.w);
      *(float4*)(BU + (2 * lane) * 16 + 4 * c4) = ore;
      *(float4*)(BU + (2 * lane + 1) * 16 + 4 * c4) = oim;
    }
  }
  wave_lds_sync();
  const int l15 = lane & 15, kg = lane >> 4;
  bf16x8 bfrag[8];
#pragma unroll
  for (int nt = 0; nt < 8; ++nt) {
    const int n = 16 * nt + l15;
#pragma unroll
    for (int j = 0; j < 8; ++j) bfrag[nt][j] = 0;
    if (kg < 2) {
      float4 x0 = *(const float4*)(BU + n * 16 + 8 * kg), x1 = *(const float4*)(BU + n * 16 + 8 * kg + 4);
      bfrag[nt][0] = (short)f2bf(x0.x); bfrag[nt][1] = (short)f2bf(x0.y); bfrag[nt][2] = (short)f2bf(x0.z); bfrag[nt][3] = (short)f2bf(x0.w);
      bfrag[nt][4] = (short)f2bf(x1.x); bfrag[nt][5] = (short)f2bf(x1.y); bfrag[nt][6] = (short)f2bf(x1.z); bfrag[nt][7] = (short)f2bf(x1.w);
    }
  }
  wave_lds_sync();
  bf16x8 cfrag[4];
  {
    const float* cr = p.c_re + ((size_t)pg * 16 + l15) * 64;
    const float* ci = p.c_im + ((size_t)pg * 16 + l15) * 64;
#pragma unroll
    for (int s = 0; s < 4; ++s) {
      float4 r4 = *(const float4*)(cr + 16 * s + 4 * kg), i4 = *(const float4*)(ci + 16 * s + 4 * kg);
      cfrag[s][0] = (short)f2bf(r4.x); cfrag[s][1] = (short)f2bf(-i4.x);
      cfrag[s][2] = (short)f2bf(r4.y); cfrag[s][3] = (short)f2bf(-i4.y);
      cfrag[s][4] = (short)f2bf(r4.z); cfrag[s][5] = (short)f2bf(-i4.z);
      cfrag[s][6] = (short)f2bf(r4.w); cfrag[s][7] = (short)f2bf(-i4.w);
    }
  }
  const u16* proj = (const u16*)(ws_ + OFF_PROJ);
  auto rowof = [&](int ci_, int tt) -> int {
    if (ci_ < 16) { int q = ci_ * 16 + tt; int pos = dir ? 255 - q : q; return MLAT + b * 256 + pos; }
    int q = (ci_ - 16) * 16 + tt; int pos = dir ? 2047 - q : q; return b * 2048 + pos;
  };
  auto loadu = [&](int ci_) -> bf16x8 {
    bf16x8 u;
#pragma unroll
    for (int j = 0; j < 8; ++j) u[j] = 0;
    if (kg < 2) u = *(const bf16x8*)(proj + (size_t)rowof(ci_, l15) * INW + 1536 + 16 * g + 8 * kg);
    return u;
  };
  float h_re = 0.f, h_im = 0.f;
  bf16x8 ucur = loadu(0), un1 = loadu(1), un2 = loadu(2);
  for (int ci = 0; ci < 144; ++ci) {
    bf16x8 un3 = loadu(ci + 3 < 144 ? ci + 3 : 143);
#pragma unroll
    for (int nt = 0; nt < 8; ++nt) {
      f32x4 z = {0.f, 0.f, 0.f, 0.f};
      f32x4 a = MFMA16(bfrag[nt], ucur, z);
      *(f32x4*)(BU + l15 * 132 + 16 * nt + 4 * kg) = a;
    }
    wave_lds_sync();
    float2 bu[16];
#pragma unroll
    for (int tt = 0; tt < 16; ++tt) bu[tt] = *(const float2*)(BU + tt * 132 + 2 * lane);
    unsigned hp[16];
#pragma unroll
    for (int tt = 0; tt < 16; ++tt) {
      float nr = a_re * h_re - a_im * h_im + bu[tt].x;
      float ni = a_re * h_im + a_im * h_re + bu[tt].y;
      h_re = nr; h_im = ni;
      hp[tt] = pack2(h_re, h_im);
    }
#pragma unroll
    for (int tt = 0; tt < 16; ++tt) HS[tt * 68 + lane] = hp[tt];
    wave_lds_sync();
    if (ci >= 16 || need_ctx) {
      f32x4 y = {0.f, 0.f, 0.f, 0.f};
#pragma unroll
      for (int s = 0; s < 4; ++s) {
        bf16x8 af = *(const bf16x8*)(HS + l15 * 68 + 16 * s + 4 * kg);
        y = MFMA16(af, cfrag[s], y);
      }
#pragma unroll
      for (int e = 0; e < 4; ++e) {
        int row = rowof(ci, 4 * kg + e);
        ysd[(size_t)row * 256 + 16 * g + l15] = f2bf(y[e]);
      }
    }
    wave_lds_sync();
    ucur = un1; un1 = un2; un2 = un3;
  }
}

DI void mixers_phase(const Params& p, int L, char* smem, bool dup, int wid_s) {
  char* const ws_ = WSL(p);
  __shared__ int s_item;
  const bool need_ctx = (L == 0);
  const int tid = ((wid_s << 6) | lane_l()), wid = wid_s;
  int* ctr = (int*)(ws_ + OFF_CTR) + L + (dup ? 2 : 0);
  const int N_S5 = 64, N_DFT = 128, N_DFTC = need_ctx ? 16 : 0, N_GA = 512, N_GAC = need_ctx ? 64 : 0, N_NA = 512, N_NAC = need_ctx ? 64 : 0;
  const int E1 = N_S5, E2 = E1 + N_DFT, E3 = E2 + N_DFTC, E4 = E3 + N_GA, E5 = E4 + N_GAC, E6 = E5 + N_NA, E7 = E6 + N_NAC;
  u16* oraw = (u16*)(ws_ + OFF_ORAW);
  for (;;) {
    if (tid == 0) s_item = atomicAdd(ctr, 1);
    __syncthreads();
    const int it = s_item;
    __syncthreads();
    if (it >= E7) break;
    if (dup) {
      const int cls = it < E1 ? 1 : (it < E3 ? 2 : (it < E5 ? 4 : 8));
      if (!(REP_SUB & cls)) continue;
    }
    if (it < E1) {
      s5_wave(p, L, it * NW + wid, need_ctx, smem + wid * 12800, dup ? (u16*)p.out : (u16*)(ws_ + OFF_YS), wid_s);
    } else if (it < E2) {
      GemmArgs g{};
      g.A = ws_ + OFF_DFTN; g.Bt = (const u16*)(ws_ + OFF_FINT);
      g.M = 2048; g.N = 4096; g.K = 2048; g.outb = (u16*)(ws_ + OFF_Z); g.npos = 2048;
      int t = it - E1;
      gemm256_tile<EPI_DFT>(g, (t >> 4) * 256, (t & 15) * 256, smem, wid_s);
    } else if (it < E3) {
      GemmArgs g{};
      g.A = ws_ + OFF_DFTC; g.Bt = (const u16*)(ws_ + OFF_FINTC);
      g.M = 256; g.N = 4096; g.K = 256; g.outb = (u16*)(ws_ + OFF_Z); g.npos = 256;
      int t = it - E2;
      gemm256_tile<EPI_DFT>(g, (t >> 4) * 256, (t & 15) * 256, smem, wid_s);
    } else if (it < E4) {
      int t = it - E3;
      int qb = t & 15, kvh = (t >> 4) & 1, b = t >> 5;
      int hd = 2 * kvh + (wid >> 2);
      int q0 = qb * 128 + (wid & 3) * 32;
      const u16* Q = (const u16*)(ws_ + OFF_AQ) + ((size_t)(b * 4 + hd) * SL + q0) * 64;
      const char* K = ws_ + OFF_AK + (size_t)(b * 2 + kvh) * SL * 128;
      const char* V = ws_ + OFF_AVT + (size_t)(b * 2 + kvh) * 72 * 4096;
      attn_block<false>(Q, K, V, 0, 36, 0, 0, oraw + (size_t)(b * 2048 + q0) * 1024 + hd * 64, nullptr, 0, 0, 0, smem, wid_s);
    } else if (it < E5) {
      int t = it - E4;
      int qb = t & 1, kvh = (t >> 1) & 1, b = t >> 2;
      int hd = 2 * kvh + (wid >> 2);
      int q0 = qb * 128 + (wid & 3) * 32;
      const u16* Q = (const u16*)(ws_ + OFF_AQ) + ((size_t)(b * 4 + hd) * SL + 2048 + q0) * 64;
      const char* K = ws_ + OFF_AK + (size_t)(b * 2 + kvh) * SL * 128;
      const char* V = ws_ + OFF_AVT + (size_t)(b * 2 + kvh) * 72 * 4096;
      attn_block<false>(Q, K, V, 32, 36, 0, 0, oraw + (size_t)(MLAT + b * 256 + q0) * 1024 + hd * 64, nullptr, 0, 0, 0, smem, wid_s);
    } else if (it < E6) {
      int t = it - E5;
      int qb = t & 7, hd = (t >> 3) & 3, b = t >> 5;
      const int r0 = qb * 4 + 2 * (wid >> 2), c0 = 16 * (wid & 3);
      int rs_lo = min(max(qb * 4 - 4, 0), 24), rs_hi = min(max(qb * 4 + 3 - 4, 0), 24);
      const u16* Qh = (const u16*)(ws_ + OFF_DQ) + (size_t)(b * 4 + hd) * SL * 64;
      const char* K = ws_ + OFF_DK + (size_t)(b * 4 + hd) * SL * 128;
      const char* V = ws_ + OFF_DVT + (size_t)(b * 4 + hd) * 72 * 4096;
      const float* bias = p.na_rel_bias + (size_t)(L * 4 + hd) * 15 * 31;
      na_block(Qh, K, V, rs_lo, rs_hi + 8, 32, 36, oraw + (size_t)(b * 2048) * 1024 + 256 + hd * 64, bias, r0, c0, smem, wid_s);
    } else {
      int t = it - E6;
      int hd = t & 3, b = t >> 2;
      int q0 = wid * 32;
      const u16* Q = (const u16*)(ws_ + OFF_DQ) + ((size_t)(b * 4 + hd) * SL + 2048 + q0) * 64;
      const char* K = ws_ + OFF_DK + (size_t)(b * 4 + hd) * SL * 128;
      const char* V = ws_ + OFF_DVT + (size_t)(b * 4 + hd) * 72 * 4096;
      attn_block<false>(Q, K, V, 32, 36, 0, 0, oraw + (size_t)(MLAT + b * 256 + q0) * 1024 + 256 + hd * 64, nullptr, 0, 0, 0, smem, wid_s);
    }
  }
}

DI void gelu_convert(const Params& p, int L, int nrows, int wid_s) {
  char* const ws_ = WSL(p);
  const u16* yf = (const u16*)(ws_ + OFF_YS);
  const u16* yb = yf + (size_t)MT * 256;
  const u16* proj = (const u16*)(ws_ + OFF_PROJ);
  u16* g16 = (u16*)(ws_ + OFF_FINT);
  const size_t n4 = (size_t)nrows * 64;
  for (size_t i = (size_t)blockIdx.x * NT + ((wid_s << 6) | lane_l()); i < n4; i += (size_t)gridDim.x * NT) {
    const size_t row = i >> 6;
    const int c4 = (int)(i & 63) * 4;
    const uint2 a = ((const uint2*)yf)[i], b = ((const uint2*)yb)[i];
    const uint2 u = *(const uint2*)(proj + row * INW + 1536 + c4);
    const float4 d = *(const float4*)(p.ssm_d + L * 256 + c4);
    const float v0 = __uint_as_float(u.x << 16) * d.x + __uint_as_float(a.x << 16) + __uint_as_float(b.x << 16);
    const float v1 = __uint_as_float(u.x & 0xffff0000u) * d.y + __uint_as_float(a.x & 0xffff0000u) + __uint_as_float(b.x & 0xffff0000u);
    const float v2 = __uint_as_float(u.y << 16) * d.z + __uint_as_float(a.y << 16) + __uint_as_float(b.y << 16);
    const float v3 = __uint_as_float(u.y & 0xffff0000u) * d.w + __uint_as_float(a.y & 0xffff0000u) + __uint_as_float(b.y & 0xffff0000u);
    ((uint2*)g16)[i] = make_uint2(pack2(gelu_tanh(v0), gelu_tanh(v1)), pack2(gelu_tanh(v2), gelu_tanh(v3)));
  }
}

#define XB_TMO      128
#define XB_XCNT(j)  (256  + 64 * (j))
#define XB_XSUB(j)  (1280 + 64 * (j))
#define XB_XGEN(j)  (2304 + 64 * (j))
#define XB_TOP      3328
#define XB_TOPGEN   3392
#define XB_SPIN_CAP (1u << 20)
#define LAS __attribute__((address_space(3)))
DI unsigned xb_ld(unsigned* p) { return __hip_atomic_load(p, __ATOMIC_RELAXED, __HIP_MEMORY_SCOPE_AGENT); }
DI unsigned xb_add(unsigned* p, unsigned v) { return __hip_atomic_fetch_add(p, v, __ATOMIC_RELAXED, __HIP_MEMORY_SCOPE_AGENT); }
DI unsigned xb_xcc_id() { return (unsigned)__builtin_amdgcn_s_getreg((3 << 11) | 20) & 0xFu; }
#define XB_SPIN(cond, bar) do { unsigned _sp = 0; while (cond) { __builtin_amdgcn_s_sleep(1); \
    if ((++_sp & 255u) == 0u) { if (xb_ld(&(bar)[XB_TMO])) break; if (_sp > XB_SPIN_CAP) { atomicAdd(&(bar)[XB_TMO], 1u); break; } } } } while (0)
struct XcdBarrier { unsigned* bar; unsigned x; volatile LAS unsigned* st; };
DI void xcd_barrier_complete(unsigned* bar, unsigned x, unsigned& nloc, unsigned& nx) {
  const unsigned G = gridDim.x;
  unsigned sum, cnt, mine, sp = 0u;
  for (;;) {
    sum = 0u; cnt = 0u; mine = 0u;
#pragma unroll
    for (unsigned j = 0; j < 16; ++j) { const unsigned c = xb_ld(&bar[XB_XCNT(j)]); sum += c; cnt += (c > 0u) ? 1u : 0u; mine = (j == x) ? c : mine; }
    if (sum == G) break;
    __builtin_amdgcn_s_sleep(1);
    if ((++sp & 255u) == 0u) { if (xb_ld(&bar[XB_TMO])) break; if (sp > XB_SPIN_CAP) { atomicAdd(&bar[XB_TMO], 1u); break; } }
  }
  nloc = mine > 0u ? mine : 1u; nx = cnt > 0u ? cnt : 1u;
}
DI void xcd_barrier(const XcdBarrier& b, bool leader_thread) {
  asm volatile("s_waitcnt vmcnt(0)" ::: "memory");
  __syncthreads();
  if (leader_thread) {
    unsigned* bar = b.bar;
    __builtin_amdgcn_s_waitcnt(0);
    unsigned nloc = b.st[0], nx = b.st[1];
    if (nloc == 0u) { xcd_barrier_complete(bar, b.x, nloc, nx); b.st[0] = nloc; b.st[1] = nx; }
    const unsigned old = xb_add(&bar[XB_XSUB(b.x)], 1u);
    const unsigned gen = old / nloc;
    if (old + 1u == (gen + 1u) * nloc) {
      __builtin_amdgcn_fence(__ATOMIC_RELEASE, "agent");
      asm volatile("s_waitcnt vmcnt(0)" ::: "memory");
      const unsigned og = xb_add(&bar[XB_TOP], 1u);
      const unsigned tg = og / nx;
      if (og + 1u == (tg + 1u) * nx) xb_add(&bar[XB_TOPGEN], 1u);
      else XB_SPIN(xb_ld(&bar[XB_TOPGEN]) == tg, bar);
      __builtin_amdgcn_fence(__ATOMIC_ACQUIRE, "agent");
      xb_add(&bar[XB_XGEN(b.x)], 1u);
      asm volatile("s_waitcnt vmcnt(0)" ::: "memory");
    } else {
      XB_SPIN(xb_ld(&bar[XB_XGEN(b.x)]) == gen, bar);
      __builtin_amdgcn_fence(__ATOMIC_ACQUIRE, "agent");
      asm volatile("s_waitcnt vmcnt(0)" ::: "memory");
    }
  }
  __syncthreads();
}

__global__ void __launch_bounds__(NT, 2) mega_fwd(Params p) {
  extern __shared__ __attribute__((aligned(16))) char smem[];
  cg::grid_group grid = cg::this_grid();
  int ph = 0;
  const int wid_s = __builtin_amdgcn_readfirstlane((int)(threadIdx.x >> 6));
  __shared__ uint4 xb_words;
  if (threadIdx.x == 0) xb_words = make_uint4(0u, 0u, 0u, 0u);
  __syncthreads();
  XcdBarrier xb;
  xb.bar = (unsigned*)(p.ws + OFF_BAR); xb.x = xb_xcc_id(); xb.st = (volatile LAS unsigned*)&xb_words;
  if (threadIdx.x == 0) (void)xb_add(&xb.bar[XB_XCNT(xb.x)], 1u);
#define GSYNC() do { if (ph == 0) grid.sync(); else xcd_barrier(xb, wid_s == 0 && lane_l() == 0); } while (0)
#define PHASE_BEGIN if (ph >= p.phase_begin && ph < p.phase_end) { size_t z_ = 0; asm volatile("" : "+s"(z_)); char* w_ = p.ws + z_; const int nrep_ = 1 + ((p.rep_mask >> ph) & 1); for (int rep_ = 0; rep_ < nrep_; ++rep_) { const bool dup = rep_ > 0; (void)dup;
#define PHASE_END   if (rep_ + 1 < nrep_) GSYNC(); } if (ph + 1 < p.phase_end) GSYNC(); } ++ph;

  PHASE_BEGIN phase0(p, smem, wid_s); PHASE_END

#define mod ((float*)(w_ + OFF_MOD))
#define xc ((float*)(w_ + OFF_XC))
#define modl (mod + (size_t)L * 17 * 6144)
  for (int L = 0; L < 2; ++L) {
    const bool need_ctx = (L == 0);
    const int mrows = need_ctx ? MT : MLAT;
    PHASE_BEGIN
      norm_phase(L == 0 ? p.x : p.out, L == 0 ? p.ctx : xc, p.g_norm1 + L * 1024, modl, 0, 1, (u16*)(w_ + OFF_H), MT, wid_s);
    PHASE_END
    PHASE_BEGIN
      GemmArgs g{};
      g.A = w_ + OFF_H; g.Bt = (const u16*)(w_ + OFF_WIN + L * SZ_WIN);
      g.M = MT; g.N = INW; g.K = DM; g.outb = (u16*)(w_ + OFF_PROJ); g.ldo = INW;
      gemm_phase<EPI_BF16>(g, smem, wid_s);
    PHASE_END
    PHASE_BEGIN
      prep_setup(p, L, smem, wid_s);
      for (int it = blockIdx.x; it < 16 * 72; it += gridDim.x) prep_item(p, L, it, smem, wid_s);
    PHASE_END
    PHASE_BEGIN mixers_phase(p, L, smem, dup, wid_s); PHASE_END
    PHASE_BEGIN
      {
        GemmArgs g{};
        g.A = w_ + OFF_Z; g.Bt = (const u16*)(w_ + OFF_WCOMB + L * SZ_WCOMB);
        g.M = mrows; g.N = 256; g.K = 512; g.outb = (u16*)(w_ + OFF_ORAW) + 512; g.ldo = 1024;
        gemm_phase<EPI_BF16>(g, smem, wid_s);
      }
      gelu_convert(p, L, mrows, wid_s);
    PHASE_END
    PHASE_BEGIN
      GemmArgs g{};
      g.A = w_ + OFF_FINT; g.Bt = (const u16*)(w_ + OFF_WGLU + L * SZ_WGLU);
      g.M = mrows; g.N = 256; g.K = 256; g.outb = (u16*)(w_ + OFF_ORAW);
      g.aux0 = (const float*)(w_ + OFF_FINT); g.aux1 = p.b_glu + L * 256;
      gemm_phase<EPI_GLU>(g, smem, wid_s);
    PHASE_END
    PHASE_BEGIN
      groupnorm_phase((const u16*)(w_ + OFF_ORAW), p.g_group + L * 1024, (u16*)(w_ + OFF_H), mrows, wid_s);
    PHASE_END
    PHASE_BEGIN
      GemmArgs g{};
      g.A = w_ + OFF_H; g.Bt = (const u16*)(w_ + OFF_WOUT + L * SZ_WOUT);
      g.M = mrows; g.N = DM; g.K = DM;
      g.aux0 = modl + 2 * 1024;
      g.src_lat = L == 0 ? p.x : p.out; g.src_ctx = p.ctx; g.dst_lat = p.out; g.dst_ctx = xc;
      gemm_phase<EPI_RESID>(g, smem, wid_s);
    PHASE_END
    PHASE_BEGIN
      norm_phase(p.out, xc, p.g_norm2 + L * 1024, modl, 3, 4, (u16*)(w_ + OFF_H), mrows, wid_s);
    PHASE_END
    PHASE_BEGIN
      GemmArgs g{};
      g.A = w_ + OFF_H; g.Bt = (const u16*)(w_ + OFF_W13 + L * SZ_W13);
      g.M = mrows; g.N = 2 * DFF; g.K = DM; g.outb = (u16*)(w_ + OFF_HID); g.skip_epi = dup ? 1 : 0;
      gemm_phase<EPI_SWIGLU>(g, smem, wid_s);
    PHASE_END
    PHASE_BEGIN
      GemmArgs g{};
      g.A = w_ + OFF_HID; g.Bt = (const u16*)(w_ + OFF_W2 + L * SZ_W2);
      g.M = mrows; g.N = DM; g.K = DFF;
      g.aux0 = modl + 5 * 1024;
      g.src_lat = p.out; g.src_ctx = xc; g.dst_lat = dup ? (float*)(w_ + OFF_H) : p.out; g.dst_ctx = dup ? (float*)(w_ + OFF_H) + (size_t)MLAT * 1024 : xc;
      gemm_phase<EPI_RESID>(g, smem, wid_s);
    PHASE_END
  }
}

#undef mod
#undef xc
#undef modl
extern "C" void kernel_launch(void* const* d_in, const int* in_sizes, int n_in, void* d_out, int out_size, void* d_ws,
                              size_t ws_size, hipStream_t stream) {
  static int grid_blocks = 0;
  if (!grid_blocks) {
    int dev = 0, cus = 0, per_cu = 0;
    (void)hipGetDevice(&dev);
    (void)hipDeviceGetAttribute(&cus, hipDeviceAttributeMultiprocessorCount, dev);
    (void)hipFuncSetAttribute((const void*)mega_fwd, hipFuncAttributeMaxDynamicSharedMemorySize, LDS_BYTES);
    (void)hipOccupancyMaxActiveBlocksPerMultiprocessor(&per_cu, (const void*)mega_fwd, NT, LDS_BYTES);
    if (per_cu < 1) per_cu = 1;
    if (per_cu > 1) per_cu = 1;
    grid_blocks = cus * per_cu;
    if (ws_size < WS_END) fprintf(stderr, "workspace too small: %zu < %zu\n", ws_size, (size_t)WS_END);
  }
  Params p{};
  const float** pp = (const float**)&p;
  for (int i = 0; i < 30; ++i) pp[i] = (const float*)d_in[i];
  p.out = (float*)d_out;
  p.ws = (char*)d_ws;
  p.phase_begin = 0;
  p.phase_end = 23;
  p.rep_mask = REP_MASK;
  (void)hipMemsetAsync((char*)d_ws + OFF_CTR, 0, 256 + 16384, stream);
  void* args[] = {&p};
  hipError_t e = hipLaunchCooperativeKernel((void*)mega_fwd, dim3(grid_blocks), dim3(NT), args, LDS_BYTES, stream);
  if (e != hipSuccess) fprintf(stderr, "cooperative launch failed: %s (grid %d)\n", hipGetErrorString(e), grid_blocks);
}
```
